# Optimizing an MI355X kernel written in HIP

```python
import math
import jax, jax.numpy as jnp
from jax import lax
import numpy as np

D_MODEL = 2048
BATCH = 2
SEQ = 4096
DEPTH = 1

A_HEADS = 16
A_KV_HEADS = 4
A_HEAD_DIM = 64
A_GROUP = A_HEADS // A_KV_HEADS
WINDOW = 128
A_BLOCK = 128
A_Q_WIDTH = A_HEADS * A_HEAD_DIM
A_KV_WIDTH = A_KV_HEADS * A_HEAD_DIM
N_BUCKETS = 32
MAX_DISTANCE = 128
B_HEADS = 4
B_KEY_DIM = 128
B_VAL_DIM = 256
B_QK_WIDTH = B_HEADS * B_KEY_DIM
B_V_WIDTH = B_HEADS * B_VAL_DIM
B_GATE_RANK = 16
B_GATE_TAU = 16.0
B_CHUNK = 64
D_FF = -(-(8 * D_MODEL) // (3 * 256)) * 256
EPS = 1e-6
NEG_INF = -1e30

IN_SPLITS = (A_Q_WIDTH, A_KV_WIDTH, A_KV_WIDTH,
             B_QK_WIDTH, B_QK_WIDTH, B_V_WIDTH, B_GATE_RANK, B_V_WIDTH,
             D_MODEL, D_MODEL)
IN_WIDTH = sum(IN_SPLITS)

kernel_name = "hybrid_swa_sink_gla_gated_merge"


def rmsnorm(x, g):
    xf = x.astype(jnp.float32)
    y = xf * lax.rsqrt(jnp.mean(xf * xf, axis=-1, keepdims=True) + EPS)
    return (y * g.astype(jnp.float32)).astype(x.dtype)


def t5_causal_bucket(dist):
    max_exact = N_BUCKETS // 2
    d = jnp.maximum(dist, 0)
    large = max_exact + (jnp.log(jnp.maximum(d, 1).astype(jnp.float32) / max_exact)
                         / math.log(MAX_DISTANCE / max_exact)
                         * (N_BUCKETS - max_exact)).astype(jnp.int32)
    large = jnp.minimum(large, N_BUCKETS - 1)
    return jnp.where(d < max_exact, d, large)


def sliding_window_attention(q, k, v, sinks, rel_bias):
    B, S = q.shape[0], q.shape[1]
    nb = S // A_BLOCK
    qb = (q * (A_HEAD_DIM ** -0.5)).reshape(B, nb, A_BLOCK, A_KV_HEADS, A_GROUP, A_HEAD_DIM)
    pad = ((0, 0), (A_BLOCK, 0), (0, 0), (0, 0))
    kp = jnp.pad(k, pad).reshape(B, nb + 1, A_BLOCK, A_KV_HEADS, A_HEAD_DIM)
    vp = jnp.pad(v, pad).reshape(B, nb + 1, A_BLOCK, A_KV_HEADS, A_HEAD_DIM)
    kb = jnp.concatenate([kp[:, :-1], kp[:, 1:]], axis=2)
    vb = jnp.concatenate([vp[:, :-1], vp[:, 1:]], axis=2)
    s = jnp.einsum('bnqkgd,bnskd->bnkgqs', qb, kb).astype(jnp.float32)
    q_loc = jnp.arange(A_BLOCK)[:, None] + A_BLOCK
    k_loc = jnp.arange(2 * A_BLOCK)[None, :]
    dist = q_loc - k_loc
    band = (dist >= 0) & (dist < WINDOW)
    k_abs = jnp.arange(nb)[:, None, None] * A_BLOCK + k_loc[None] - A_BLOCK
    mask = band[None] & (k_abs >= 0)
    bias = rel_bias.astype(jnp.float32)[t5_causal_bucket(dist)]
    bias = bias.transpose(2, 0, 1).reshape(A_KV_HEADS, A_GROUP, A_BLOCK, 2 * A_BLOCK)
    s = jnp.where(mask[None, :, None, None], s + bias[None, None], NEG_INF)
    sink = sinks.astype(jnp.float32).reshape(A_KV_HEADS, A_GROUP)[None, None, :, :, None, None]
    m = jnp.maximum(jnp.max(s, axis=-1, keepdims=True), sink)
    p = jnp.exp(s - m)
    denom = jnp.sum(p, axis=-1, keepdims=True) + jnp.exp(sink - m)
    o = jnp.einsum('bnkgqs,bnskd->bnqkgd', (p / denom).astype(v.dtype), vb)
    return o.reshape(B, S, A_Q_WIDTH)


def gated_linear_attention(q, k, v, log_a):
    B, S = q.shape[0], q.shape[1]
    nc = S // B_CHUNK

    def chunks(t):
        return t.astype(jnp.float32).reshape(B, nc, B_CHUNK, B_HEADS, -1).transpose(0, 3, 1, 2, 4)

    qc = chunks(q) * (B_KEY_DIM ** -0.5)
    kc, vc, gc = chunks(k), chunks(v), chunks(log_a)
    b = jnp.cumsum(gc, axis=3)
    b_last = b[:, :, :, -1:, :]
    q_dec = qc * jnp.exp(b)
    k_dec = kc * jnp.exp(-b)
    k_state = kc * jnp.exp(b_last - b)
    causal = jnp.tril(jnp.ones((B_CHUNK, B_CHUNK), dtype=bool))
    att = jnp.where(causal, jnp.einsum('bhncd,bhnsd->bhncs', q_dec, k_dec), 0.0)
    o_intra = jnp.einsum('bhncs,bhnsv->bhncv', att, vc)
    dS = jnp.einsum('bhncd,bhncv->bhndv', k_state, vc)
    decay = jnp.exp(b_last[:, :, :, 0, :])

    def step(state, inp):
        dS_n, decay_n = inp
        return decay_n[..., None] * state + dS_n, state

    s0 = jnp.zeros((B, B_HEADS, B_KEY_DIM, B_VAL_DIM), jnp.float32)
    _, s_prev = lax.scan(step, s0, (dS.transpose(2, 0, 1, 3, 4), decay.transpose(2, 0, 1, 3)))
    s_prev = s_prev.transpose(1, 2, 0, 3, 4)
    o_inter = jnp.einsum('bhncd,bhndv->bhncv', q_dec, s_prev)
    o = o_intra + o_inter
    return o.transpose(0, 2, 3, 1, 4).reshape(B, S, B_HEADS, B_VAL_DIM)


def setup_inputs(seed: int = 0) -> dict:
    key = jax.random.key(seed)
    ks = jax.random.split(key, 20)
    L = DEPTH

    def w(k, shape, fan_in):
        return jax.random.normal(k, shape, jnp.float32) * (fan_in ** -0.5)

    def gain(k, shape):
        return 1.0 + 0.02 * jax.random.normal(k, shape, jnp.float32)

    return {
        "x": jax.random.normal(ks[0], (BATCH, SEQ, D_MODEL), jnp.float32),
        "norm_mix_g": gain(ks[1], (L, D_MODEL)),
        "w_in": w(ks[2], (L, D_MODEL, IN_WIDTH), D_MODEL),
        "sinks": 0.5 * jax.random.normal(ks[3], (L, A_HEADS), jnp.float32),
        "rel_bias": 0.5 * jax.random.normal(ks[4], (N_BUCKETS, A_HEADS), jnp.float32),
        "w_gate_up": w(ks[5], (L, B_GATE_RANK, B_QK_WIDTH), B_GATE_RANK),
        "b_gate": 0.1 * jax.random.normal(ks[6], (L, B_QK_WIDTH), jnp.float32),
        "gla_norm_g": gain(ks[7], (L, B_VAL_DIM)),
        "w_proj_a": w(ks[8], (L, A_Q_WIDTH, D_MODEL), A_Q_WIDTH),
        "w_proj_b": w(ks[9], (L, B_V_WIDTH, D_MODEL), B_V_WIDTH),
        "w_out": w(ks[10], (L, D_MODEL, D_MODEL), D_MODEL),
        "norm_ffn_g": gain(ks[11], (L, D_MODEL)),
        "w_ffn_gate": w(ks[12], (L, D_MODEL, D_FF), D_MODEL),
        "w_ffn_up": w(ks[13], (L, D_MODEL, D_FF), D_MODEL),
        "w_ffn_down": w(ks[14], (L, D_FF, D_MODEL), D_FF),
        "norm_final_g": gain(ks[15], (D_MODEL,)),
    }


def reference(x, norm_mix_g, w_in, sinks, rel_bias, w_gate_up, b_gate, gla_norm_g,
              w_proj_a, w_proj_b, w_out, norm_ffn_g, w_ffn_gate, w_ffn_up, w_ffn_down,
              norm_final_g):
    B, S = x.shape[0], x.shape[1]
    split_idx = [int(i) for i in np.cumsum(IN_SPLITS)[:-1]]
    h = x
    for l in range(DEPTH):
        u = rmsnorm(h, norm_mix_g[l])
        proj = u @ w_in[l]
        qa, ka, va, qb, kb, vb, g_low, ob_gate, gate_a, gate_b = jnp.split(proj, split_idx, axis=-1)
        ya = sliding_window_attention(
            qa.reshape(B, S, A_HEADS, A_HEAD_DIM),
            ka.reshape(B, S, A_KV_HEADS, A_HEAD_DIM),
            va.reshape(B, S, A_KV_HEADS, A_HEAD_DIM),
            sinks[l], rel_bias)
        ya = ya @ w_proj_a[l]
        log_a = jax.nn.log_sigmoid((g_low @ w_gate_up[l] + b_gate[l]).astype(jnp.float32)) / B_GATE_TAU
        ob = gated_linear_attention(
            qb.reshape(B, S, B_HEADS, B_KEY_DIM),
            kb.reshape(B, S, B_HEADS, B_KEY_DIM),
            vb.reshape(B, S, B_HEADS, B_VAL_DIM),
            log_a.reshape(B, S, B_HEADS, B_KEY_DIM))
        ob = rmsnorm(ob, gla_norm_g[l]).reshape(B, S, B_V_WIDTH).astype(x.dtype)
        yb = (ob * jax.nn.silu(ob_gate)) @ w_proj_b[l]
        merged = jax.nn.sigmoid(gate_a) * ya + jax.nn.sigmoid(gate_b) * yb
        h = h + (merged @ w_out[l]).astype(h.dtype)
        z = rmsnorm(h, norm_ffn_g[l])
        ff = (jax.nn.silu(z @ w_ffn_gate[l]) * (z @ w_ffn_up[l])) @ w_ffn_down[l]
        h = h + ff.astype(h.dtype)
    return rmsnorm(h, norm_final_g)
```

```cpp
#include <hip/hip_runtime.h>
#include <hip/hip_cooperative_groups.h>
#include <cstdio>
#include <cstdint>
namespace cg = cooperative_groups;

#ifndef MK_N_LAUNCHES
#define MK_N_LAUNCHES 1
#endif

#define LAS __attribute__((address_space(3)))
typedef unsigned short bf16_t;
typedef short bf16x8 __attribute__((ext_vector_type(8)));
typedef short s16x4 __attribute__((ext_vector_type(4)));
typedef float f32x4 __attribute__((ext_vector_type(4)));
typedef float f32x2 __attribute__((ext_vector_type(2)));
typedef float f32x16 __attribute__((ext_vector_type(16)));
typedef unsigned u32x4 __attribute__((ext_vector_type(4)));
typedef unsigned u32x2 __attribute__((ext_vector_type(2)));
typedef _Float16 f16x8 __attribute__((ext_vector_type(8)));
typedef __bf16 bf16x2_t __attribute__((ext_vector_type(2)));

constexpr int BATCH = 2, SEQ = 4096, M = BATCH * SEQ, D = 2048;
constexpr int IN_W = 8720, NIN = 8960;
constexpr int AQ = 1024, AKV = 256, BQK = 512, BV = 1024, RANK = 16, FF = 5632;
constexpr float EPS = 1e-6f, LOG2E = 1.4426950408889634f;
constexpr float QA_SCALE = 0.125f * LOG2E;
constexpr float QB_SCALE = 0.08838834764831845f;

constexpr size_t MiB = 1u << 20;
constexpr size_t WS_BAR = 0;
constexpr size_t WS_RSTD1 = 64 * 1024;
constexpr size_t WS_STAT2 = 128 * 1024;
constexpr size_t WS_STAT3 = 384 * 1024;
constexpr size_t WS_DEC = 640 * 1024;
constexpr size_t WS_GLOW = 1 * MiB;
constexpr size_t WS_PA = 4 * MiB, WS_PB = 8 * MiB, WS_WOUT = 12 * MiB, WS_WGU = 20 * MiB, WS_WD = 64 * MiB;
constexpr size_t WS_WIN = 86 * MiB, WS_XB = 121 * MiB;
constexpr size_t WS_STATE = 86 * MiB;
constexpr size_t WS_MERGED = 118 * MiB;
constexpr size_t WS_HB = 86 * MiB;
constexpr size_t WS_QA = 153 * MiB, WS_KA = 169 * MiB, WS_VA = 173 * MiB, WS_QB = 177 * MiB, WS_KB = 185 * MiB, WS_VB = 193 * MiB, WS_OG = 209 * MiB, WS_GA = 225 * MiB, WS_GB = 257 * MiB;
constexpr size_t WS_H = 153 * MiB;
constexpr size_t WS_END = 289 * MiB;

constexpr int RING_BYTES = 131072;
constexpr int XL_OFF = RING_BYTES + 1024;
constexpr int LDS_BYTES = 147456;
constexpr int NWAVES = 8;

__device__ __forceinline__ unsigned cvtpk(float lo, float hi) { f32x2 v = {lo, hi}; bf16x2_t b = __builtin_convertvector(v, bf16x2_t); return __builtin_bit_cast(unsigned, b); }
__device__ __forceinline__ bf16_t f2bf(float f) { return (bf16_t)(cvtpk(f, 0.f) & 0xffffu); }
__device__ __forceinline__ float bf2f(bf16_t b) { return __builtin_bit_cast(float, (unsigned)b << 16); }
__device__ __forceinline__ float bflo(unsigned w) { return __builtin_bit_cast(float, w << 16); }
__device__ __forceinline__ float bfhi(unsigned w) { return __builtin_bit_cast(float, w & 0xffff0000u); }
__device__ __forceinline__ float sigmoidf_(float v) { return __builtin_amdgcn_rcpf(1.f + __builtin_amdgcn_exp2f(-v * LOG2E)); }
__device__ __forceinline__ float wave_sum(float v) {
#pragma unroll
    for (int o = 1; o < 64; o <<= 1) v += __shfl_xor(v, o);
    return v;
}
__device__ __forceinline__ int crow(int r, int hi) { return (r & 3) + 8 * (r >> 2) + 4 * hi; }
#define LDS_WAIT() asm volatile("s_waitcnt lgkmcnt(0)" ::: "memory")
#define VM_WAIT() asm volatile("s_waitcnt vmcnt(0)" ::: "memory")

namespace pg8 {
constexpr int BM = 256, BK = 64, HALF = 128, HTB = HALF * BK * 2, NXCD = 8, WGM = 8;
__host__ __device__ __forceinline__ int lds_byte(int r, int c) { const int st = (r >> 4) * 2 + (c >> 5), rr = r & 15, cc = c & 31, ob = rr * 64 + cc * 2; return st * 1024 + (ob ^ (((ob >> 9) & 1) << 5)); }
__host__ __device__ __forceinline__ void stage_rc(int b, int& R, int& C) { const int st = b / 1024, sb = b % 1024, swz = sb ^ (((sb >> 9) & 1) << 5); R = (st >> 1) * 16 + swz / 64; C = (st & 1) * 32 + (swz % 64) / 2; }
__host__ __device__ __forceinline__ int perm32(int rho) { const int n = rho >> 4, i = rho & 15; return 8 * (i >> 2) + 4 * n + (i & 3); }

struct Unit { int pm, pn, seg; };
struct Gemm { const bf16_t* A0; const bf16_t* A1; const bf16_t* B0; const bf16_t* B1; int K; };

struct StaticOrder {
    int nM, nN, nwg, G, c, two;
    __device__ void init(int M_, int N_, int G_, int c_, int two_) { nM = M_ / BM; nN = N_ / BM; nwg = nM * nN; G = G_; c = c_; two = two_; }
    __device__ bool next(int i, Unit& u) const {
        const int ti = two ? (i >> 1) : i; u.seg = two ? (i & 1) : 0;
        const long L = (long)ti * G + c; if (L >= nwg) return false;
        int wgid = (int)L; { const int q = nwg / NXCD, r = nwg % NXCD, xcd = wgid % NXCD, off = wgid / NXCD; wgid = (xcd < r ? xcd * (q + 1) : r * (q + 1) + (xcd - r) * q) + off; }
        const int nig = WGM * nN, gid = wgid / nig, fm = gid * WGM, gsz = (nM - fm) < WGM ? (nM - fm) : WGM;
        u.pm = fm + ((wgid % nig) % gsz); u.pn = (wgid % nig) / gsz; return true;
    }
};

typedef f32x4 Acc[2][2][4][2];

template <class Epi, class Sched>
__device__ __forceinline__ void gemm_phase(LAS unsigned char* lds, const Gemm g, const Sched& S, const Epi& E) {
    const int tid = threadIdx.x, wid = __builtin_amdgcn_readfirstlane(tid >> 6), lane = tid & 63, wr = wid >> 2, wc = wid & 3, fr = lane & 15, fq = lane >> 4;
    const int K = g.K, nt = K / BK;
    unsigned voffA[2], voffB[2];
#pragma unroll
    for (int i = 0; i < 2; ++i) { int R, C; stage_rc(tid * 16 + i * 8192, R, C); const int Rb = (R & ~31) + perm32(R & 31);
        voffA[i] = (unsigned)(R * K + C) * 2u; voffB[i] = (unsigned)(Rb * K + C) * 2u; }
    const size_t kstep = (size_t)(BK * 2);
    const size_t hstep = (size_t)HALF * K * 2;
    const size_t tstep = 2 * hstep;
    const unsigned ldsw = (unsigned)wid * 1024u;
    const int aoff = lds_byte(wr * 64 + fr, fq * 8), boff = lds_byte(wc * 32 + fr, fq * 8);
#define PG8_SA(b, h) (((b) * 2 + (h)) * HTB)
#define PG8_SB(b, h) ((4 + (b) * 2 + (h)) * HTB)
#define PG8_STAGE(bufoff, gbase, voff) do { _Pragma("unroll") for (int _i = 0; _i < 2; ++_i) \
        __builtin_amdgcn_global_load_lds((const unsigned*)((const char*)(gbase) + (voff)[_i]), (LAS unsigned*)(lds + (bufoff) + ldsw + _i * 8192), 16, 0, 0); } while (0)
#define PG8_LDA(dst, b, h) do { _Pragma("unroll") for (int m = 0; m < 4; ++m) _Pragma("unroll") for (int k = 0; k < 2; ++k) dst[m][k] = *(const LAS bf16x8*)(lds + PG8_SA(b, h) + aoff + m * 2048 + k * 1024); } while (0)
#define PG8_LDB(dst, b, h) do { _Pragma("unroll") for (int n = 0; n < 2; ++n) _Pragma("unroll") for (int k = 0; k < 2; ++k) dst[n][k] = *(const LAS bf16x8*)(lds + PG8_SB(b, h) + boff + n * 2048 + k * 1024); } while (0)
#define PG8_MMA(ai, bj, At, Bt) do { __builtin_amdgcn_s_setprio(1); _Pragma("unroll") for (int m = 0; m < 4; ++m) _Pragma("unroll") for (int n = 0; n < 2; ++n) _Pragma("unroll") for (int k = 0; k < 2; ++k) \
        acc[ai][bj][m][n] = __builtin_amdgcn_mfma_f32_16x16x32_bf16(Bt[n][k], At[m][k], acc[ai][bj][m][n], 0, 0, 0); __builtin_amdgcn_s_setprio(0); } while (0)
#define PG8_WAIT_V(n) asm volatile("s_waitcnt vmcnt(" #n ")" ::: "memory")
#define PG8_WAIT_L(n) asm volatile("s_waitcnt lgkmcnt(" #n ")" ::: "memory")
#define PG8_BAR __builtin_amdgcn_s_barrier()
#define PG8_SCHED __builtin_amdgcn_sched_barrier(0)
#define PG8_UA(u) ((const char*)((u).seg ? g.A1 : g.A0) + (size_t)(u).pm * tstep)
#define PG8_UB(u) ((const char*)((u).seg ? g.B1 : g.B0) + (size_t)(u).pn * tstep)
    Unit cur, nxt; int ui = 0;
    if (!S.next(0, cur)) return;
    Acc acc;
#pragma unroll
    for (int a = 0; a < 2; ++a)
#pragma unroll
        for (int b = 0; b < 2; ++b)
#pragma unroll
            for (int m = 0; m < 4; ++m)
#pragma unroll
                for (int n = 0; n < 2; ++n) acc[a][b][m][n] = (f32x4){0.f, 0.f, 0.f, 0.f};
    bf16x8 At[4][2], B0[2][2], B1[2][2];
    const char* cA = PG8_UA(cur); const char* cB = PG8_UB(cur);
    PG8_STAGE(PG8_SB(0, 0), cB, voffB); PG8_STAGE(PG8_SB(0, 1), cB + hstep, voffB); PG8_STAGE(PG8_SA(0, 0), cA, voffA); PG8_STAGE(PG8_SA(0, 1), cA + hstep, voffA);
    if (wr == 1) PG8_BAR;
    PG8_WAIT_V(2); PG8_BAR;
    PG8_STAGE(PG8_SB(1, 0), cB + kstep, voffB); PG8_STAGE(PG8_SA(1, 0), cA + kstep, voffA); PG8_STAGE(PG8_SB(1, 1), cB + hstep + kstep, voffB);
    PG8_WAIT_V(6); PG8_BAR;
    for (;;) {
        const bool has_next = S.next(ui + 1, nxt);
        const char* nA = has_next ? PG8_UA(nxt) : cA; const char* nB = has_next ? PG8_UB(nxt) : cB;
        for (int t = 0; t < nt; t += 2) {
            const bool last = (t == nt - 2);
            const char* a1 = cA + (size_t)(t + 1) * kstep;
            const char* a2 = last ? nA : cA + (size_t)(t + 2) * kstep; const char* b2 = last ? nB : cB + (size_t)(t + 2) * kstep;
            const char* a3 = a2 + kstep; const char* b3 = b2 + kstep;
            PG8_LDB(B0, 0, 0); PG8_LDB(B1, 0, 1); PG8_SCHED; PG8_LDA(At, 0, 0); PG8_STAGE(PG8_SA(1, 1), a1 + hstep, voffA);
            PG8_WAIT_V(8); PG8_WAIT_L(0); PG8_BAR; PG8_MMA(0, 0, At, B0); PG8_MMA(0, 1, At, B1); PG8_BAR; PG8_SCHED;
            PG8_LDA(At, 0, 1); PG8_STAGE(PG8_SB(0, 0), b2, voffB); PG8_STAGE(PG8_SB(0, 1), b2 + hstep, voffB); PG8_STAGE(PG8_SA(0, 0), a2, voffA);
            PG8_WAIT_V(8); PG8_WAIT_L(0); PG8_BAR; PG8_MMA(1, 0, At, B0); PG8_MMA(1, 1, At, B1); PG8_BAR; PG8_SCHED;
            PG8_LDB(B0, 1, 0); PG8_LDB(B1, 1, 1); PG8_SCHED; PG8_LDA(At, 1, 0); PG8_STAGE(PG8_SA(0, 1), a2 + hstep, voffA);
            PG8_WAIT_V(8); PG8_WAIT_L(0); PG8_BAR; PG8_MMA(0, 0, At, B0); PG8_MMA(0, 1, At, B1); PG8_BAR; PG8_SCHED;
            PG8_LDA(At, 1, 1); PG8_STAGE(PG8_SB(1, 0), b3, voffB); PG8_STAGE(PG8_SB(1, 1), b3 + hstep, voffB); PG8_STAGE(PG8_SA(1, 0), a3, voffA);
            PG8_WAIT_V(8); PG8_WAIT_L(0); PG8_BAR; PG8_MMA(1, 0, At, B0); PG8_MMA(1, 1, At, B1); PG8_BAR; PG8_SCHED;
        }
        if (wr == 0) PG8_BAR;
        const bool keep = E(acc, cur, wr, wc, fr, fq, lds, tid);
        if (!has_next) break;
        if (!keep) {
#pragma unroll
            for (int a = 0; a < 2; ++a)
#pragma unroll
                for (int b = 0; b < 2; ++b)
#pragma unroll
                    for (int m = 0; m < 4; ++m)
#pragma unroll
                        for (int n = 0; n < 2; ++n) acc[a][b][m][n] = (f32x4){0.f, 0.f, 0.f, 0.f};
        }
        cur = nxt; cA = nA; cB = nB; ++ui;
        if (wr == 1) PG8_BAR;
    }
    PG8_WAIT_V(0);
    PG8_BAR;
#undef PG8_SA
#undef PG8_SB
#undef PG8_STAGE
#undef PG8_LDA
#undef PG8_LDB
#undef PG8_MMA
#undef PG8_WAIT_V
#undef PG8_WAIT_L
#undef PG8_SCHED
#undef PG8_UA
#undef PG8_UB
}
#define PG8_EPI_BARRIER() do { asm volatile("s_waitcnt lgkmcnt(0)" ::: "memory"); __builtin_amdgcn_s_barrier(); asm volatile("" ::: "memory"); } while (0)

template <int ACT> __device__ __forceinline__ u32x4 pack8(f32x4 v0, f32x4 v1, float sc) {
    float x[8] = {v0[0], v0[1], v0[2], v0[3], v1[0], v1[1], v1[2], v1[3]};
    u32x4 w;
    if (ACT == 2) {
        f16x8 h;
#pragma unroll
        for (int i = 0; i < 8; ++i) h[i] = (_Float16)sigmoidf_(x[i]);
        w = __builtin_bit_cast(u32x4, h);
    } else {
#pragma unroll
        for (int i = 0; i < 8; ++i) x[i] = (ACT == 1) ? x[i] * sigmoidf_(x[i]) : x[i] * sc;
        w.x = cvtpk(x[0], x[1]); w.y = cvtpk(x[2], x[3]); w.z = cvtpk(x[4], x[5]); w.w = cvtpk(x[6], x[7]);
    }
    return w;
}
template <int ACT> __device__ __forceinline__ void store_tile16(const Acc& acc, const Unit& u, int wr, int wc, int fr, int fq, bf16_t* base, int ld, int coff, float sc, const float* rstd) {
    const int row0 = u.pm * BM + wr * 64 + fr, col0 = coff + wc * 32 + 8 * fq;
#pragma unroll
    for (int ai = 0; ai < 2; ++ai)
#pragma unroll
        for (int m = 0; m < 4; ++m) { const int row = row0 + ai * HALF + m * 16; const float rs = rstd[row]; bf16_t* rowp = base + (size_t)row * ld + col0;
#pragma unroll
            for (int bj = 0; bj < 2; ++bj) *(u32x4*)(rowp + bj * HALF) = pack8<ACT>(acc[ai][bj][m][0] * rs, acc[ai][bj][m][1] * rs, sc); }
}
struct EpiIn {
    bf16_t *QA, *KA, *VA, *QB, *KB, *VB, *OG, *GA, *GB; float* GLOW; const float* rstd;
    __device__ __forceinline__ bool operator()(const Acc& acc, const Unit& u, int wr, int wc, int fr, int fq, LAS unsigned char*, int) const {
        const int pn = u.pn;
        if (pn < 4) store_tile16<0>(acc, u, wr, wc, fr, fq, QA, AQ, pn * 256, QA_SCALE, rstd);
        else if (pn == 4) store_tile16<0>(acc, u, wr, wc, fr, fq, KA, AKV, 0, 1.f, rstd);
        else if (pn == 5) store_tile16<0>(acc, u, wr, wc, fr, fq, VA, AKV, 0, 1.f, rstd);
        else if (pn < 8) store_tile16<0>(acc, u, wr, wc, fr, fq, QB, BQK, (pn - 6) * 256, 1.f, rstd);
        else if (pn < 10) store_tile16<0>(acc, u, wr, wc, fr, fq, KB, BQK, (pn - 8) * 256, 1.f, rstd);
        else if (pn < 14) store_tile16<0>(acc, u, wr, wc, fr, fq, VB, BV, (pn - 10) * 256, 1.f, rstd);
        else if (pn < 18) store_tile16<1>(acc, u, wr, wc, fr, fq, OG, BV, (pn - 14) * 256, 1.f, rstd);
        else if (pn < 26) store_tile16<2>(acc, u, wr, wc, fr, fq, GA, D, (pn - 18) * 256, 1.f, rstd);
        else if (pn < 34) store_tile16<2>(acc, u, wr, wc, fr, fq, GB, D, (pn - 26) * 256, 1.f, rstd);
        else if (wc == 0 && fq < 2) {
            const int row0 = u.pm * BM + wr * 64 + fr;
#pragma unroll
            for (int ai = 0; ai < 2; ++ai)
#pragma unroll
                for (int m = 0; m < 4; ++m) { const int row = row0 + ai * HALF + m * 16; const float rs = rstd[row]; float* p = GLOW + (size_t)row * RANK + 8 * fq;
                    *(f32x4*)p = acc[ai][0][m][0] * rs; *(f32x4*)(p + 4) = acc[ai][0][m][1] * rs; }
        }
        return false;
    }
};
struct EpiMerge {
    const _Float16 *GA, *GB; bf16_t* OUT;
    __device__ __forceinline__ bool operator()(Acc& acc, const Unit& u, int wr, int wc, int fr, int fq, LAS unsigned char*, int) const {
        const int row0 = u.pm * BM + wr * 64 + fr, col0 = u.pn * BM + wc * 32 + 8 * fq;
#pragma unroll
        for (int ai = 0; ai < 2; ++ai)
#pragma unroll
            for (int m = 0; m < 4; ++m) { const size_t off = (size_t)(row0 + ai * HALF + m * 16) * D + col0;
#pragma unroll
                for (int bj = 0; bj < 2; ++bj) {
                    const f16x8 gb = *(const f16x8*)(GB + off + bj * HALF);
                    if (u.seg == 0) {
                        const f16x8 ga = *(const f16x8*)(GA + off + bj * HALF);
#pragma unroll
                        for (int i = 0; i < 4; ++i) { acc[ai][bj][m][0][i] *= (float)ga[i] * __builtin_amdgcn_rcpf((float)gb[i]); acc[ai][bj][m][1][i] *= (float)ga[4 + i] * __builtin_amdgcn_rcpf((float)gb[4 + i]); }
                    } else {
                        f32x4 v0, v1;
#pragma unroll
                        for (int i = 0; i < 4; ++i) { v0[i] = acc[ai][bj][m][0][i] * (float)gb[i]; v1[i] = acc[ai][bj][m][1][i] * (float)gb[4 + i]; }
                        *(u32x4*)(OUT + off + bj * HALF) = pack8<0>(v0, v1, 1.f);
                    }
                } }
        return u.seg == 0;
    }
};
template <bool WITH_BF> struct EpiRes {
    const float* base; float* out; bf16_t* hb; float* stat;
    __device__ __forceinline__ bool operator()(const Acc& acc, const Unit& u, int wr, int wc, int fr, int fq, LAS unsigned char* lds, int tid) const {
        LAS float* XL = (LAS float*)(lds + XL_OFF);
        const int row0 = u.pm * BM + wr * 64 + fr, col0 = u.pn * BM + wc * 32 + 8 * fq;
#pragma unroll
        for (int ai = 0; ai < 2; ++ai)
#pragma unroll
            for (int m = 0; m < 4; ++m) { const int rl = ai * HALF + wr * 64 + m * 16 + fr; const size_t off = (size_t)(row0 + ai * HALF + m * 16) * D + col0; float ss = 0.f;
#pragma unroll
                for (int bj = 0; bj < 2; ++bj) {
                    const f32x4 b0 = *(const f32x4*)(base + off + bj * HALF), b1 = *(const f32x4*)(base + off + bj * HALF + 4);
                    const f32x4 h0 = b0 + acc[ai][bj][m][0], h1 = b1 + acc[ai][bj][m][1];
                    *(f32x4*)(out + off + bj * HALF) = h0; *(f32x4*)(out + off + bj * HALF + 4) = h1;
                    if (WITH_BF) *(u32x4*)(hb + off + bj * HALF) = pack8<0>(h0, h1, 1.f);
                    ss += (h0[0] * h0[0] + h0[1] * h0[1]) + (h0[2] * h0[2] + h0[3] * h0[3]) + (h1[0] * h1[0] + h1[1] * h1[1]) + (h1[2] * h1[2] + h1[3] * h1[3]);
                }
                ss += __shfl_xor(ss, 16); ss += __shfl_xor(ss, 32);
                if (fq == 0) XL[rl * 4 + wc] = ss; }
        PG8_EPI_BARRIER();
        if (tid < 256) { const f32x4 p = *(const LAS f32x4*)(XL + tid * 4); stat[(size_t)(u.pm * BM + tid) * 8 + u.pn] = (p[0] + p[1]) + (p[2] + p[3]); }
        PG8_EPI_BARRIER();
        return false;
    }
};
struct EpiGU {
    const float* stat; bf16_t* H;
    __device__ __forceinline__ bool operator()(const Acc& acc, const Unit& u, int wr, int wc, int fr, int fq, LAS unsigned char*, int) const {
        const int row0 = u.pm * BM + wr * 64 + fr, col0 = u.pn * HALF + wc * 32 + 8 * fq;
#pragma unroll
        for (int ai = 0; ai < 2; ++ai)
#pragma unroll
            for (int m = 0; m < 4; ++m) { const int row = row0 + ai * HALF + m * 16;
                const f32x4 s0 = *(const f32x4*)(stat + (size_t)row * 8), s1 = *(const f32x4*)(stat + (size_t)row * 8 + 4);
                const float rs = __builtin_amdgcn_rsqf(((s0[0] + s0[1]) + (s0[2] + s0[3]) + (s1[0] + s1[1]) + (s1[2] + s1[3])) * (1.f / D) + EPS);
                f32x4 v0, v1;
#pragma unroll
                for (int i = 0; i < 4; ++i) { const float g0 = acc[ai][0][m][0][i] * rs, g1 = acc[ai][0][m][1][i] * rs;
                    v0[i] = g0 * sigmoidf_(g0) * (acc[ai][1][m][0][i] * rs); v1[i] = g1 * sigmoidf_(g1) * (acc[ai][1][m][1][i] * rs); }
                *(u32x4*)(H + (size_t)row * FF + col0) = pack8<0>(v0, v1, 1.f); }
        return false;
    }
};
}

struct Args { const float* in[16]; float* out; unsigned char* ws; int ph_lo, ph_hi; };
struct Frame { LAS unsigned char* lds; int tid, lane, wave, G, bid; };

template <int MODE> __device__ __forceinline__ int dest_row(int n) {
    if (MODE == 1) return n < 3584 ? n : (n < 3600 ? 8704 + (n - 3584) : n - 16);
    if (MODE == 2) return 256 * (n >> 7) + (n & 127);
    if (MODE == 3) return 256 * (n >> 7) + 128 + (n & 127);
    return n;
}
template <int MODE> __device__ __forceinline__ void p0_transpose_item(const float* W, int K, int N, bf16_t* WT, const float* gk, LAS float* scr, int item, int lane) {
    const int nblk = (N + 31) / 32, kb = item / nblk, nb = item % nblk, k0 = 64 * kb, n0 = 32 * nb;
    const bool nok = (n0 + (lane & 31)) < N;
#pragma unroll 8
    for (int i = 0; i < 32; ++i) { const int kk = 2 * i + (lane >> 5); float v = nok ? W[(size_t)(k0 + kk) * N + n0 + (lane & 31)] : 0.f; if (gk) v *= gk[k0 + kk]; scr[kk * 33 + (lane & 31)] = v; }
    LDS_WAIT(); asm volatile("" ::: "memory");
    const int c = lane & 7;
#pragma unroll
    for (int j = 0; j < 4; ++j) { const int n = (lane >> 3) + 8 * j; const LAS float* s = scr + (8 * c) * 33 + n;
        u32x4 o; o.x = cvtpk(s[0 * 33], s[1 * 33]); o.y = cvtpk(s[2 * 33], s[3 * 33]); o.z = cvtpk(s[4 * 33], s[5 * 33]); o.w = cvtpk(s[6 * 33], s[7 * 33]);
        if (n0 + n < N) *(u32x4*)(WT + (size_t)dest_row<MODE>(n0 + n) * K + k0 + 8 * c) = o; }
    LDS_WAIT(); asm volatile("" ::: "memory");
}
__device__ __forceinline__ void p0_prologue(const Frame& F, const Args& a) {
    unsigned char* ws = a.ws;
    LAS float* scr = (LAS float*)(F.lds + F.wave * 16384);
    const int gw = F.bid * NWAVES + F.wave, NGW = F.G * NWAVES;
    constexpr int I_IN = (D / 64) * ((IN_W + 31) / 32), I_PA = (AQ / 64) * (D / 32), I_PB = (BV / 64) * (D / 32), I_WO = (D / 64) * (D / 32), I_G = (D / 64) * (FF / 32), I_D = (FF / 64) * (D / 32);
    constexpr int NITEMS = I_IN + I_PA + I_PB + I_WO + 2 * I_G + I_D;
    for (int it = gw; it < NITEMS; it += NGW) {
        int r = it;
        if (r < I_IN) { p0_transpose_item<1>(a.in[2], D, IN_W, (bf16_t*)(ws + WS_WIN), a.in[1], scr, r, F.lane); continue; } r -= I_IN;
        if (r < I_PA) { p0_transpose_item<0>(a.in[8], AQ, D, (bf16_t*)(ws + WS_PA), nullptr, scr, r, F.lane); continue; } r -= I_PA;
        if (r < I_PB) { p0_transpose_item<0>(a.in[9], BV, D, (bf16_t*)(ws + WS_PB), nullptr, scr, r, F.lane); continue; } r -= I_PB;
        if (r < I_WO) { p0_transpose_item<0>(a.in[10], D, D, (bf16_t*)(ws + WS_WOUT), nullptr, scr, r, F.lane); continue; } r -= I_WO;
        if (r < I_G) { p0_transpose_item<2>(a.in[12], D, FF, (bf16_t*)(ws + WS_WGU), a.in[11], scr, r, F.lane); continue; } r -= I_G;
        if (r < I_G) { p0_transpose_item<3>(a.in[13], D, FF, (bf16_t*)(ws + WS_WGU), a.in[11], scr, r, F.lane); continue; } r -= I_G;
        p0_transpose_item<0>(a.in[14], FF, D, (bf16_t*)(ws + WS_WD), nullptr, scr, r, F.lane);
    }
    { u32x4* z = (u32x4*)(ws + WS_WIN + (size_t)IN_W * D * 2); const int nz = (NIN - IN_W) * D * 2 / 16;
      for (int i = F.bid * 512 + F.tid; i < nz; i += F.G * 512) z[i] = (u32x4){0u, 0u, 0u, 0u}; }
    const float* x = a.in[0]; bf16_t* XB = (bf16_t*)(ws + WS_XB); float* RS = (float*)(ws + WS_RSTD1);
    for (int m = gw; m < M; m += NGW) {
        const f32x4* xr = (const f32x4*)(x + (size_t)m * D) + F.lane; f32x4 v[8]; float s = 0.f;
#pragma unroll
        for (int j = 0; j < 8; ++j) { v[j] = xr[64 * j]; s += (v[j][0] * v[j][0] + v[j][1] * v[j][1]) + (v[j][2] * v[j][2] + v[j][3] * v[j][3]); }
        s = wave_sum(s);
        u32x2* o = (u32x2*)(XB + (size_t)m * D) + F.lane;
#pragma unroll
        for (int j = 0; j < 8; ++j) o[64 * j] = (u32x2){cvtpk(v[j][0], v[j][1]), cvtpk(v[j][2], v[j][3])};
        if (F.lane == 0) RS[m] = __builtin_amdgcn_rsqf(s * (1.f / D) + EPS);
    }
}

__device__ __forceinline__ unsigned short elem16(const u32x4& v, int e) { const unsigned w = v[e >> 1]; return (unsigned short)((e & 1) ? (w >> 16) : (w & 0xffffu)); }
constexpr int SW_KS = 72, SW_VS = 264;
__device__ __forceinline__ void swa_unit(const Frame& F, const Args& a, int u) {
    const int b = u >> 7, blk = (u >> 2) & 31, kvh = u & 3;
    const int tid = F.tid, lane = F.lane, w = F.wave, l31 = lane & 31, hi = lane >> 5;
    unsigned char* ws = a.ws;
    bf16_t* QA = (bf16_t*)(ws + WS_QA); const bf16_t* KA = (const bf16_t*)(ws + WS_KA); const bf16_t* VA = (const bf16_t*)(ws + WS_VA);
    LAS bf16_t* Ks = (LAS bf16_t*)(F.lds);
    LAS bf16_t* VT = (LAS bf16_t*)(F.lds + 256 * SW_KS * 2);
    LAS float* BT = (LAS float*)(F.lds + 256 * SW_KS * 2 + 64 * SW_VS * 2);
    const long r0 = (long)b * SEQ + blk * 128;
#pragma unroll
    for (int i = 0; i < 4; ++i) { const int p = tid + 512 * i, row = p >> 3, ch = p & 7; const long grow = r0 - 128 + row;
        u32x4 kv = (u32x4){0u, 0u, 0u, 0u}, vv = (u32x4){0u, 0u, 0u, 0u};
        if (blk > 0 || row >= 128) { kv = *(const u32x4*)(KA + grow * AKV + kvh * 64 + ch * 8); vv = *(const u32x4*)(VA + grow * AKV + kvh * 64 + ch * 8); }
        *(LAS u32x4*)(Ks + row * SW_KS + ch * 8) = kv;
#pragma unroll
        for (int e = 0; e < 8; ++e) VT[(ch * 8 + e) * SW_VS + row] = elem16(vv, e); }
    { const int hq = tid >> 7, dist = tid & 127;
      int bucket = dist;
      if (dist >= 16) { bucket = 16 + (int)(__logf((float)dist * (1.f / 16.f)) * (16.f / 2.0794415416798357f)); bucket = bucket > 31 ? 31 : bucket; }
      BT[tid] = a.in[4][bucket * 16 + kvh * 4 + hq] * LOG2E; }
    __syncthreads();
    const int hq = w >> 1, head = kvh * 4 + hq;
    const float sinkv = a.in[3][head] * LOG2E;
#pragma unroll 1
    for (int qt = 0; qt < 2; ++qt) {
        const int i0 = 64 * (w & 1) + 32 * qt;
        bf16x8 qf[4];
#pragma unroll
        for (int ds = 0; ds < 4; ++ds) qf[ds] = *(const bf16x8*)(QA + (r0 + i0 + l31) * AQ + head * 64 + 16 * ds + 8 * hi);
        f32x16 p[5];
#pragma unroll
        for (int kt = 0; kt < 5; ++kt) { p[kt] = (f32x16){};
#pragma unroll
            for (int ds = 0; ds < 4; ++ds) { const bf16x8 kf = *(const LAS bf16x8*)(Ks + (i0 + 32 * kt + l31) * SW_KS + 16 * ds + 8 * hi);
                p[kt] = __builtin_amdgcn_mfma_f32_32x32x16_bf16(kf, qf[ds], p[kt], 0, 0, 0); } }
        const int q = i0 + l31; float mx = sinkv;
#pragma unroll
        for (int kt = 0; kt < 5; ++kt)
#pragma unroll
            for (int r = 0; r < 16; ++r) { const int j = i0 + 32 * kt + crow(r, hi), dist = q + 128 - j;
                const bool valid = dist >= 0 && dist < 128 && (blk > 0 || j >= 128);
                const float s = valid ? p[kt][r] + BT[hq * 128 + (dist & 127)] : -1e30f;
                p[kt][r] = s; mx = fmaxf(mx, s); }
        mx = fmaxf(mx, __shfl_xor(mx, 32));
        float sum = 0.f;
#pragma unroll
        for (int kt = 0; kt < 5; ++kt)
#pragma unroll
            for (int r = 0; r < 16; ++r) { const float e = __builtin_amdgcn_exp2f(p[kt][r] - mx); p[kt][r] = e; sum += e; }
        sum += __shfl_xor(sum, 32);
        sum += __builtin_amdgcn_exp2f(sinkv - mx);
        const float inv = 1.f / sum;
        f32x16 o[2]; o[0] = (f32x16){}; o[1] = (f32x16){};
#pragma unroll
        for (int kt = 0; kt < 5; ++kt)
#pragma unroll
            for (int s2 = 0; s2 < 2; ++s2) {
                u32x4 pw;
#pragma unroll
                for (int i = 0; i < 4; ++i) pw[i] = cvtpk(p[kt][8 * s2 + 2 * i] * inv, p[kt][8 * s2 + 2 * i + 1] * inv);
                const bf16x8 pa = __builtin_bit_cast(bf16x8, pw);
#pragma unroll
                for (int dh = 0; dh < 2; ++dh) { const LAS bf16_t* vp = VT + (32 * dh + l31) * SW_VS + i0 + 32 * kt + 16 * s2 + 4 * hi;
                    const s16x4 lo = *(const LAS s16x4*)vp, hi4 = *(const LAS s16x4*)(vp + 8);
                    const bf16x8 vb = (bf16x8){lo[0], lo[1], lo[2], lo[3], hi4[0], hi4[1], hi4[2], hi4[3]};
                    o[dh] = __builtin_amdgcn_mfma_f32_32x32x16_bf16(pa, vb, o[dh], 0, 0, 0); } }
#pragma unroll
        for (int dh = 0; dh < 2; ++dh)
#pragma unroll
            for (int r = 0; r < 16; ++r) QA[(r0 + i0 + crow(r, hi)) * AQ + head * 64 + 32 * dh + l31] = f2bf(o[dh][r]);
    }
    __syncthreads();
}

constexpr int GL_S = 72;
__device__ __forceinline__ void gla_stage_vt(const Frame& F, const bf16_t* VB, long t0, int h, LAS bf16_t* VT) {
#pragma unroll
    for (int i = 0; i < 4; ++i) { const int p = F.tid + 512 * i, s = p >> 5, ch = p & 31;
        const u32x4 vv = *(const u32x4*)(VB + (t0 + s) * BV + h * 256 + ch * 8);
#pragma unroll
        for (int e = 0; e < 8; ++e) VT[(ch * 8 + e) * GL_S + s] = elem16(vv, e); }
}
__device__ __forceinline__ void gla_a_unit(const Frame& F, const Args& a, int u) {
    const int b = u >> 8, h = (u >> 6) & 3, c = u & 63;
    const int tid = F.tid, lane = F.lane, w = F.wave, l31 = lane & 31, hi = lane >> 5;
    unsigned char* ws = a.ws;
    bf16_t* QB = (bf16_t*)(ws + WS_QB); bf16_t* KB = (bf16_t*)(ws + WS_KB); const bf16_t* VB = (const bf16_t*)(ws + WS_VB);
    const float* GLOW = (const float*)(ws + WS_GLOW); float* DEC = (float*)(ws + WS_DEC); bf16_t* ST = (bf16_t*)(ws + WS_STATE) + (size_t)u * 32768;
    LAS float* GL = (LAS float*)F.lds;
    LAS float* TOT = (LAS float*)(F.lds + 4096);
    LAS bf16_t* KsT = (LAS bf16_t*)(F.lds + 8192);
    LAS bf16_t* VT = (LAS bf16_t*)(F.lds + 8192 + 128 * GL_S * 2);
    const long t0 = (long)b * SEQ + 64 * c;
    if (tid < 256) *(LAS f32x4*)(GL + tid * 4) = *(const f32x4*)(GLOW + (size_t)t0 * RANK + tid * 4);
    gla_stage_vt(F, VB, t0, h, VT);
    const int d = tid & 127, sg = tid >> 7;
    float wg[16];
#pragma unroll
    for (int r = 0; r < 16; ++r) wg[r] = a.in[5][r * BQK + h * 128 + d];
    const float bg = a.in[6][h * 128 + d];
    __syncthreads();
    float bl[16]; float run = 0.f;
#pragma unroll
    for (int i = 0; i < 16; ++i) { const int s = sg * 16 + i; float G = bg;
#pragma unroll
        for (int r4 = 0; r4 < 4; ++r4) { const f32x4 gv = *(const LAS f32x4*)(GL + s * 16 + r4 * 4); G += gv[0] * wg[4 * r4] + gv[1] * wg[4 * r4 + 1] + gv[2] * wg[4 * r4 + 2] + gv[3] * wg[4 * r4 + 3]; }
        const float ls = fminf(G, 0.f) - __logf(1.f + __expf(-fabsf(G)));
        run += ls * (1.f / 16.f); bl[i] = run; }
    TOT[sg * 128 + d] = run;
    __syncthreads();
    float off = 0.f, tot = 0.f;
#pragma unroll
    for (int g = 0; g < 4; ++g) { const float t = TOT[g * 128 + d]; if (g < sg) off += t; tot += t; }
#pragma unroll
    for (int i = 0; i < 16; ++i) { const int s = sg * 16 + i; const float bb = off + bl[i]; const size_t gi = (size_t)(t0 + s) * BQK + h * 128 + d;
        const float qv = bf2f(QB[gi]), kv = bf2f(KB[gi]);
        QB[gi] = f2bf(qv * __expf(bb) * QB_SCALE); KB[gi] = f2bf(kv * __expf(-bb)); KsT[d * GL_S + s] = f2bf(kv * __expf(tot - bb)); }
    if (sg == 0) DEC[u * 128 + d] = __expf(tot);
    __syncthreads();
    bf16x8 af[4];
#pragma unroll
    for (int st = 0; st < 4; ++st) af[st] = *(const LAS bf16x8*)(VT + (32 * w + l31) * GL_S + 16 * st + 8 * hi);
#pragma unroll
    for (int dt = 0; dt < 4; ++dt) { f32x16 acc = (f32x16){};
#pragma unroll
        for (int st = 0; st < 4; ++st) { const bf16x8 bfr = *(const LAS bf16x8*)(KsT + (32 * dt + l31) * GL_S + 16 * st + 8 * hi); acc = __builtin_amdgcn_mfma_f32_32x32x16_bf16(af[st], bfr, acc, 0, 0, 0); }
#pragma unroll
        for (int r = 0; r < 16; ++r) ST[(32 * w + crow(r, hi)) * 128 + 32 * dt + l31] = f2bf(acc[r]); }
    __syncthreads();
}

__device__ __forceinline__ void gla_scan(const Frame& F, const Args& a) {
    unsigned char* ws = a.ws; unsigned* ST = (unsigned*)(ws + WS_STATE); const float* DEC = (const float*)(ws + WS_DEC);
    for (int idx = F.bid * 512 + F.tid; idx < 8 * 16384; idx += F.G * 512) {
        const int bh = idx >> 14, e2 = idx & 16383, d0 = (e2 * 2) & 127;
        unsigned* p = ST + (size_t)bh * 64 * 16384 + e2; const float* dp = DEC + (size_t)bh * 64 * 128 + d0;
        float s0 = 0.f, s1 = 0.f;
#pragma unroll 8
        for (int c = 0; c < 64; ++c) { const unsigned x = p[(size_t)c * 16384]; const f32x2 dc = *(const f32x2*)(dp + c * 128);
            p[(size_t)c * 16384] = cvtpk(s0, s1); s0 = dc[0] * s0 + bflo(x); s1 = dc[1] * s1 + bfhi(x); }
    }
}

constexpr int OS_S = 260;
__device__ __forceinline__ void gla_c_unit(const Frame& F, const Args& a, int u) {
    const int b = u >> 8, h = (u >> 6) & 3, c = u & 63;
    const int lane = F.lane, w = F.wave, l31 = lane & 31, hi = lane >> 5;
    unsigned char* ws = a.ws;
    const bf16_t* QB = (const bf16_t*)(ws + WS_QB); const bf16_t* KB = (const bf16_t*)(ws + WS_KB); bf16_t* VB = (bf16_t*)(ws + WS_VB);
    const bf16_t* OG = (const bf16_t*)(ws + WS_OG); const bf16_t* ST = (const bf16_t*)(ws + WS_STATE) + (size_t)u * 32768;
    LAS bf16_t* VT = (LAS bf16_t*)F.lds;
    LAS float* OS = (LAS float*)(F.lds + 256 * GL_S * 2);
    const long t0 = (long)b * SEQ + 64 * c;
    gla_stage_vt(F, VB, t0, h, VT);
    const int ct = w & 1, vt0 = (w >> 1) * 2;
    bf16x8 qf[8];
#pragma unroll
    for (int st = 0; st < 8; ++st) qf[st] = *(const bf16x8*)(QB + (t0 + 32 * ct + l31) * BQK + h * 128 + 16 * st + 8 * hi);
    f32x16 aT[2];
#pragma unroll
    for (int sti = 0; sti < 2; ++sti) { aT[sti] = (f32x16){};
        if (sti <= ct) {
#pragma unroll
            for (int st = 0; st < 8; ++st) { const bf16x8 kf = *(const bf16x8*)(KB + (t0 + 32 * sti + l31) * BQK + h * 128 + 16 * st + 8 * hi);
                aT[sti] = __builtin_amdgcn_mfma_f32_32x32x16_bf16(kf, qf[st], aT[sti], 0, 0, 0); }
#pragma unroll
            for (int r = 0; r < 16; ++r) if (32 * sti + crow(r, hi) > 32 * ct + l31) aT[sti][r] = 0.f;
        } }
    __syncthreads();
    f32x16 o[2];
#pragma unroll
    for (int j = 0; j < 2; ++j) { o[j] = (f32x16){};
        const int vrow = 32 * (vt0 + j) + l31;
#pragma unroll
        for (int st = 0; st < 8; ++st) { const bf16x8 sf = *(const bf16x8*)(ST + vrow * 128 + 16 * st + 8 * hi); o[j] = __builtin_amdgcn_mfma_f32_32x32x16_bf16(qf[st], sf, o[j], 0, 0, 0); }
#pragma unroll
        for (int sti = 0; sti < 2; ++sti) if (sti <= ct) {
#pragma unroll
            for (int s2 = 0; s2 < 2; ++s2) { u32x4 pw;
#pragma unroll
                for (int i = 0; i < 4; ++i) pw[i] = cvtpk(aT[sti][8 * s2 + 2 * i], aT[sti][8 * s2 + 2 * i + 1]);
                const LAS bf16_t* vp = VT + vrow * GL_S + 32 * sti + 16 * s2 + 4 * hi;
                const s16x4 lo = *(const LAS s16x4*)vp, hi4 = *(const LAS s16x4*)(vp + 8);
                const bf16x8 vb = (bf16x8){lo[0], lo[1], lo[2], lo[3], hi4[0], hi4[1], hi4[2], hi4[3]};
                o[j] = __builtin_amdgcn_mfma_f32_32x32x16_bf16(__builtin_bit_cast(bf16x8, pw), vb, o[j], 0, 0, 0); } }
#pragma unroll
        for (int r = 0; r < 16; ++r) OS[(32 * ct + crow(r, hi)) * OS_S + 32 * (vt0 + j) + l31] = o[j][r]; }
    __syncthreads();
    const f32x4 gn = *(const f32x4*)(a.in[7] + 4 * lane);
#pragma unroll
    for (int i = 0; i < 8; ++i) { const int row = 8 * w + i; const f32x4 v = *(const LAS f32x4*)(OS + row * OS_S + 4 * lane);
        const float ss = wave_sum((v[0] * v[0] + v[1] * v[1]) + (v[2] * v[2] + v[3] * v[3]));
        const float rs = __builtin_amdgcn_rsqf(ss * (1.f / 256.f) + EPS);
        const size_t gi = (size_t)(t0 + row) * BV + h * 256 + 4 * lane; const u32x2 og = *(const u32x2*)(OG + gi);
        *(u32x2*)(VB + gi) = (u32x2){cvtpk(v[0] * rs * gn[0] * bflo(og[0]), v[1] * rs * gn[1] * bfhi(og[0])), cvtpk(v[2] * rs * gn[2] * bflo(og[1]), v[3] * rs * gn[3] * bfhi(og[1]))}; }
    __syncthreads();
}

__device__ __forceinline__ void final_norm(const Frame& F, const Args& a) {
    const float* stat = (const float*)(a.ws + WS_STAT3); const float* gf = a.in[15];
    const int gw = F.bid * NWAVES + F.wave, NGW = F.G * NWAVES;
    for (int m = gw; m < M; m += NGW) {
        const f32x4 s0 = *(const f32x4*)(stat + (size_t)m * 8), s1 = *(const f32x4*)(stat + (size_t)m * 8 + 4);
        const float rs = __builtin_amdgcn_rsqf(((s0[0] + s0[1]) + (s0[2] + s0[3]) + (s1[0] + s1[1]) + (s1[2] + s1[3])) * (1.f / D) + EPS);
        f32x4* xr = (f32x4*)(a.out + (size_t)m * D) + F.lane; const f32x4* gr = (const f32x4*)gf + F.lane;
#pragma unroll
        for (int j = 0; j < 8; ++j) xr[64 * j] = xr[64 * j] * rs * gr[64 * j];
    }
}

constexpr int N_PHASES = 10;
__global__ void __launch_bounds__(NWAVES * 64, 2) fwd_kernel(Args args) {
    extern __shared__ __attribute__((aligned(16))) unsigned char lds_raw[];
    cg::grid_group grid = cg::this_grid();
    Frame F;
    F.lds = (LAS unsigned char*)lds_raw;
    F.tid = threadIdx.x; F.lane = F.tid & 63; F.wave = __builtin_amdgcn_readfirstlane(F.tid >> 6);
    F.G = gridDim.x; F.bid = blockIdx.x;
    unsigned char* ws = args.ws;
    const int lo = args.ph_lo, hi = args.ph_hi;
#define IN(k) (lo <= (k) && (k) < hi)
#define SEAM(k) do { if (IN(k) && IN((k) + 1)) grid.sync(); } while (0)

    if (IN(0)) { p0_prologue(F, args); } SEAM(0);

    if (IN(1)) {
        pg8::Gemm g{(const bf16_t*)(ws + WS_XB), nullptr, (const bf16_t*)(ws + WS_WIN), nullptr, D};
        pg8::StaticOrder S; S.init(M, NIN, F.G, F.bid, 0);
        pg8::EpiIn E{(bf16_t*)(ws + WS_QA), (bf16_t*)(ws + WS_KA), (bf16_t*)(ws + WS_VA), (bf16_t*)(ws + WS_QB), (bf16_t*)(ws + WS_KB), (bf16_t*)(ws + WS_VB), (bf16_t*)(ws + WS_OG),
                     (bf16_t*)(ws + WS_GA), (bf16_t*)(ws + WS_GB), (float*)(ws + WS_GLOW), (const float*)(ws + WS_RSTD1)};
        pg8::gemm_phase(F.lds, g, S, E);
    } SEAM(1);

    if (IN(2)) {
        for (int u = F.bid; u < 256; u += F.G) swa_unit(F, args, u);
        for (int u = F.bid; u < 512; u += F.G) gla_a_unit(F, args, u);
    } SEAM(2);

    if (IN(3)) { gla_scan(F, args); } SEAM(3);

    if (IN(4)) { for (int u = F.bid; u < 512; u += F.G) gla_c_unit(F, args, u); } SEAM(4);

    if (IN(5)) {
        pg8::Gemm g{(const bf16_t*)(ws + WS_QA), (const bf16_t*)(ws + WS_VB), (const bf16_t*)(ws + WS_PA), (const bf16_t*)(ws + WS_PB), AQ};
        pg8::StaticOrder S; S.init(M, D, F.G, F.bid, 1);
        pg8::EpiMerge E{(const _Float16*)(ws + WS_GA), (const _Float16*)(ws + WS_GB), (bf16_t*)(ws + WS_MERGED)};
        pg8::gemm_phase(F.lds, g, S, E);
    } SEAM(5);

    if (IN(6)) {
        pg8::Gemm g{(const bf16_t*)(ws + WS_MERGED), nullptr, (const bf16_t*)(ws + WS_WOUT), nullptr, D};
        pg8::StaticOrder S; S.init(M, D, F.G, F.bid, 0);
        pg8::EpiRes<true> E{args.in[0], args.out, (bf16_t*)(ws + WS_HB), (float*)(ws + WS_STAT2)};
        pg8::gemm_phase(F.lds, g, S, E);
    } SEAM(6);

    if (IN(7)) {
        pg8::Gemm g{(const bf16_t*)(ws + WS_HB), nullptr, (const bf16_t*)(ws + WS_WGU), nullptr, D};
        pg8::StaticOrder S; S.init(M, 2 * FF, F.G, F.bid, 0);
        pg8::EpiGU E{(const float*)(ws + WS_STAT2), (bf16_t*)(ws + WS_H)};
        pg8::gemm_phase(F.lds, g, S, E);
    } SEAM(7);

    if (IN(8)) {
        pg8::Gemm g{(const bf16_t*)(ws + WS_H), nullptr, (const bf16_t*)(ws + WS_WD), nullptr, FF};
        pg8::StaticOrder S; S.init(M, D, F.G, F.bid, 0);
        pg8::EpiRes<false> E{args.out, args.out, nullptr, (float*)(ws + WS_STAT3)};
        pg8::gemm_phase(F.lds, g, S, E);
    } SEAM(8);

    if (IN(9)) { final_norm(F, args); }
#undef IN
#undef SEAM
}

extern "C" void kernel_launch(void* const* d_in, const int* in_sizes, int n_in, void* d_out, int out_size, void* d_ws, size_t ws_size, hipStream_t stream) {
    static int grid = 0;
    if (grid == 0) {
        if (n_in != 16 || in_sizes[0] != M * D || out_size != M * D || ws_size < WS_END) { fprintf(stderr, "kernel_launch: unexpected shapes (n_in %d, in0 %d, out %d, ws %zu); nothing launched\n", n_in, n_in > 0 ? in_sizes[0] : -1, out_size, ws_size); grid = -1; return; }
        int dev = 0, cus = 0, per_cu = 0;
        if (hipGetDevice(&dev) != hipSuccess || hipDeviceGetAttribute(&cus, hipDeviceAttributeMultiprocessorCount, dev) != hipSuccess) { grid = -1; return; }
        if (hipFuncSetAttribute((const void*)fwd_kernel, hipFuncAttributeMaxDynamicSharedMemorySize, LDS_BYTES) != hipSuccess) { fprintf(stderr, "kernel_launch: hipFuncSetAttribute failed\n"); grid = -1; return; }
        if (hipOccupancyMaxActiveBlocksPerMultiprocessor(&per_cu, (const void*)fwd_kernel, NWAVES * 64, LDS_BYTES) != hipSuccess || per_cu < 1) { fprintf(stderr, "kernel_launch: occupancy query failed (%d)\n", per_cu); (void)hipGetLastError(); per_cu = 1; }
        if (per_cu > 1) per_cu = 1;
        grid = cus * per_cu;
    }
    if (grid < 0) return;
    Args a{};
    for (int i = 0; i < 16; ++i) a.in[i] = (const float*)d_in[i];
    a.out = (float*)d_out; a.ws = (unsigned char*)d_ws;
#if MK_N_LAUNCHES == 1
    a.ph_lo = 0; a.ph_hi = N_PHASES;
    void* kargs[] = {&a};
    hipError_t e = hipLaunchCooperativeKernel((const void*)fwd_kernel, dim3(grid), dim3(NWAVES * 64), kargs, LDS_BYTES, stream);
    if (e != hipSuccess) fprintf(stderr, "kernel_launch: cooperative launch failed: %s (grid %d)\n", hipGetErrorString(e), grid);
#else
    for (int ph = 0; ph < N_PHASES; ++ph) { a.ph_lo = ph; a.ph_hi = ph + 1; hipLaunchKernelGGL(fwd_kernel, dim3(grid), dim3(NWAVES * 64), LDS_BYTES, stream, a); }
#endif
}
```

```cpp
#include <hip/hip_runtime.h>
#include <cstdio>
#include <cstdint>

#ifndef MK_N_LAUNCHES
#define MK_N_LAUNCHES 1
#endif

#define LAS __attribute__((address_space(3)))
typedef unsigned short bf16_t;
typedef short bf16x8 __attribute__((ext_vector_type(8)));
typedef short s16x4 __attribute__((ext_vector_type(4)));
typedef float f32x4 __attribute__((ext_vector_type(4)));
typedef float f32x2 __attribute__((ext_vector_type(2)));
typedef float f32x16 __attribute__((ext_vector_type(16)));
typedef unsigned u32x4 __attribute__((ext_vector_type(4)));
typedef unsigned u32x2 __attribute__((ext_vector_type(2)));
typedef _Float16 f16x8 __attribute__((ext_vector_type(8)));
typedef __bf16 bf16x2_t __attribute__((ext_vector_type(2)));

constexpr int BATCH = 2, SEQ = 4096, M = BATCH * SEQ, D = 2048;
constexpr int IN_W = 8720, NIN = 8960;
constexpr int AQ = 1024, AKV = 256, BQK = 512, BV = 1024, RANK = 16, FF = 5632;
constexpr float EPS = 1e-6f, LOG2E = 1.4426950408889634f;
constexpr float QA_SCALE = 0.125f * LOG2E;
constexpr float QB_SCALE = 0.08838834764831845f;

constexpr size_t MiB = 1u << 20;
constexpr size_t WS_BAR = 0;
constexpr size_t WS_RSTD1 = 64 * 1024;
constexpr size_t WS_STAT2 = 128 * 1024;
constexpr size_t WS_STAT3 = 384 * 1024;
constexpr size_t WS_DEC = 640 * 1024;
constexpr size_t WS_GLOW = 1 * MiB;
constexpr size_t WS_PA = 4 * MiB, WS_PB = 8 * MiB, WS_WOUT = 12 * MiB, WS_WGU = 20 * MiB, WS_WD = 64 * MiB;
constexpr size_t WS_WIN = 86 * MiB, WS_XB = 121 * MiB;
constexpr size_t WS_STATE = 86 * MiB;
constexpr size_t WS_MERGED = 118 * MiB;
constexpr size_t WS_HB = 86 * MiB;
constexpr size_t WS_QA = 153 * MiB, WS_KA = 169 * MiB, WS_VA = 173 * MiB, WS_QB = 177 * MiB, WS_KB = 185 * MiB, WS_VB = 193 * MiB, WS_OG = 209 * MiB, WS_GA = 225 * MiB, WS_GB = 257 * MiB;
constexpr size_t WS_H = 153 * MiB;
constexpr size_t WS_END = 289 * MiB;

constexpr int RING_BYTES = 131072;
constexpr int XL_OFF = RING_BYTES + 1024;
constexpr int LDS_BYTES = 147456;
constexpr int NWAVES = 8;

__device__ __forceinline__ unsigned cvtpk(float lo, float hi) { f32x2 v = {lo, hi}; bf16x2_t b = __builtin_convertvector(v, bf16x2_t); return __builtin_bit_cast(unsigned, b); }
__device__ __forceinline__ bf16_t f2bf(float f) { return (bf16_t)(cvtpk(f, 0.f) & 0xffffu); }
__device__ __forceinline__ float bf2f(bf16_t b) { return __builtin_bit_cast(float, (unsigned)b << 16); }
__device__ __forceinline__ float bflo(unsigned w) { return __builtin_bit_cast(float, w << 16); }
__device__ __forceinline__ float bfhi(unsigned w) { return __builtin_bit_cast(float, w & 0xffff0000u); }
__device__ __forceinline__ float sigmoidf_(float v) { return __builtin_amdgcn_rcpf(1.f + __builtin_amdgcn_exp2f(-v * LOG2E)); }
__device__ __forceinline__ float wave_sum(float v) {
#pragma unroll
    for (int o = 1; o < 64; o <<= 1) v += __shfl_xor(v, o);
    return v;
}
__device__ __forceinline__ int crow(int r, int hi) { return (r & 3) + 8 * (r >> 2) + 4 * hi; }
#define LDS_WAIT() asm volatile("s_waitcnt lgkmcnt(0)" ::: "memory")
#define VM_WAIT() asm volatile("s_waitcnt vmcnt(0)" ::: "memory")

namespace pg8 {
constexpr int BM = 256, BK = 64, HALF = 128, HTB = HALF * BK * 2, NXCD = 8, WGM = 8;
__host__ __device__ __forceinline__ int lds_byte(int r, int c) { const int st = (r >> 4) * 2 + (c >> 5), rr = r & 15, cc = c & 31, ob = rr * 64 + cc * 2; return st * 1024 + (ob ^ (((ob >> 9) & 1) << 5)); }
__host__ __device__ __forceinline__ void stage_rc(int b, int& R, int& C) { const int st = b / 1024, sb = b % 1024, swz = sb ^ (((sb >> 9) & 1) << 5); R = (st >> 1) * 16 + swz / 64; C = (st & 1) * 32 + (swz % 64) / 2; }
__host__ __device__ __forceinline__ int perm32(int rho) { const int n = rho >> 4, i = rho & 15; return 8 * (i >> 2) + 4 * n + (i & 3); }

struct Unit { int pm, pn, seg; };
struct Gemm { const bf16_t* A0; const bf16_t* A1; const bf16_t* B0; const bf16_t* B1; int K; };

struct StaticOrder {
    int nM, nN, nwg, G, c, two;
    __device__ void init(int M_, int N_, int G_, int c_, int two_) { nM = M_ / BM; nN = N_ / BM; nwg = nM * nN; G = G_; c = c_; two = two_; }
    __device__ bool next(int i, Unit& u) const {
        const int ti = two ? (i >> 1) : i; u.seg = two ? (i & 1) : 0;
        const long L = (long)ti * G + c; if (L >= nwg) return false;
        int wgid = (int)L; { const int q = nwg / NXCD, r = nwg % NXCD, xcd = wgid % NXCD, off = wgid / NXCD; wgid = (xcd < r ? xcd * (q + 1) : r * (q + 1) + (xcd - r) * q) + off; }
        const int nig = WGM * nN, gid = wgid / nig, fm = gid * WGM, gsz = (nM - fm) < WGM ? (nM - fm) : WGM;
        u.pm = fm + ((wgid % nig) % gsz); u.pn = (wgid % nig) / gsz; return true;
    }
};

typedef f32x4 Acc[2][2][4][2];

template <class Epi, class Sched>
__device__ __forceinline__ void gemm_phase(LAS unsigned char* lds, const Gemm g, const Sched& S, const Epi& E) {
    const int tid = threadIdx.x, wid = __builtin_amdgcn_readfirstlane(tid >> 6), lane = tid & 63, wr = wid >> 2, wc = wid & 3, fr = lane & 15, fq = lane >> 4;
    const int K = g.K, nt = K / BK;
    unsigned voffA[2], voffB[2];
#pragma unroll
    for (int i = 0; i < 2; ++i) { int R, C; stage_rc(tid * 16 + i * 8192, R, C); const int Rb = (R & ~31) + perm32(R & 31);
        voffA[i] = (unsigned)(R * K + C) * 2u; voffB[i] = (unsigned)(Rb * K + C) * 2u; }
    const size_t kstep = (size_t)(BK * 2);
    const size_t hstep = (size_t)HALF * K * 2;
    const size_t tstep = 2 * hstep;
    const unsigned ldsw = (unsigned)wid * 1024u;
    const int aoff = lds_byte(wr * 64 + fr, fq * 8), boff = lds_byte(wc * 32 + fr, fq * 8);
#define PG8_SA(b, h) (((b) * 2 + (h)) * HTB)
#define PG8_SB(b, h) ((4 + (b) * 2 + (h)) * HTB)
#define PG8_STAGE(bufoff, gbase, voff) do { _Pragma("unroll") for (int _i = 0; _i < 2; ++_i) \
        __builtin_amdgcn_global_load_lds((const unsigned*)((const char*)(gbase) + (voff)[_i]), (LAS unsigned*)(lds + (bufoff) + ldsw + _i * 8192), 16, 0, 0); } while (0)
#define PG8_LDA(dst, b, h) do { _Pragma("unroll") for (int m = 0; m < 4; ++m) _Pragma("unroll") for (int k = 0; k < 2; ++k) dst[m][k] = *(const LAS bf16x8*)(lds + PG8_SA(b, h) + aoff + m * 2048 + k * 1024); } while (0)
#define PG8_LDB(dst, b, h) do { _Pragma("unroll") for (int n = 0; n < 2; ++n) _Pragma("unroll") for (int k = 0; k < 2; ++k) dst[n][k] = *(const LAS bf16x8*)(lds + PG8_SB(b, h) + boff + n * 2048 + k * 1024); } while (0)
#define PG8_MMA(ai, bj, At, Bt) do { __builtin_amdgcn_s_setprio(1); _Pragma("unroll") for (int m = 0; m < 4; ++m) _Pragma("unroll") for (int n = 0; n < 2; ++n) _Pragma("unroll") for (int k = 0; k < 2; ++k) \
        acc[ai][bj][m][n] = __builtin_amdgcn_mfma_f32_16x16x32_bf16(Bt[n][k], At[m][k], acc[ai][bj][m][n], 0, 0, 0); __builtin_amdgcn_s_setprio(0); } while (0)
#define PG8_WAIT_V(n) asm volatile("s_waitcnt vmcnt(" #n ")" ::: "memory")
#define PG8_WAIT_L(n) asm volatile("s_waitcnt lgkmcnt(" #n ")" ::: "memory")
#define PG8_BAR __builtin_amdgcn_s_barrier()
#define PG8_SCHED __builtin_amdgcn_sched_barrier(0)
#define PG8_UA(u) ((const char*)((u).seg ? g.A1 : g.A0) + (size_t)(u).pm * tstep)
#define PG8_UB(u) ((const char*)((u).seg ? g.B1 : g.B0) + (size_t)(u).pn * tstep)
    Unit cur, nxt; int ui = 0;
    if (!S.next(0, cur)) return;
    Acc acc;
#pragma unroll
    for (int a = 0; a < 2; ++a)
#pragma unroll
        for (int b = 0; b < 2; ++b)
#pragma unroll
            for (int m = 0; m < 4; ++m)
#pragma unroll
                for (int n = 0; n < 2; ++n) acc[a][b][m][n] = (f32x4){0.f, 0.f, 0.f, 0.f};
    bf16x8 At[4][2], B0[2][2], B1[2][2];
    const char* cA = PG8_UA(cur); const char* cB = PG8_UB(cur);
    PG8_STAGE(PG8_SB(0, 0), cB, voffB); PG8_STAGE(PG8_SB(0, 1), cB + hstep, voffB); PG8_STAGE(PG8_SA(0, 0), cA, voffA); PG8_STAGE(PG8_SA(0, 1), cA + hstep, voffA);
    if (wr == 1) PG8_BAR;
    PG8_WAIT_V(2); PG8_BAR;
    PG8_STAGE(PG8_SB(1, 0), cB + kstep, voffB); PG8_STAGE(PG8_SA(1, 0), cA + kstep, voffA); PG8_STAGE(PG8_SB(1, 1), cB + hstep + kstep, voffB);
    PG8_WAIT_V(6); PG8_BAR;
    for (;;) {
        const bool has_next = S.next(ui + 1, nxt);
        const char* nA = has_next ? PG8_UA(nxt) : cA; const char* nB = has_next ? PG8_UB(nxt) : cB;
        for (int t = 0; t < nt; t += 2) {
            const bool last = (t == nt - 2);
            const char* a1 = cA + (size_t)(t + 1) * kstep;
            const char* a2 = last ? nA : cA + (size_t)(t + 2) * kstep; const char* b2 = last ? nB : cB + (size_t)(t + 2) * kstep;
            const char* a3 = a2 + kstep; const char* b3 = b2 + kstep;
            PG8_LDB(B0, 0, 0); PG8_LDB(B1, 0, 1); PG8_SCHED; PG8_LDA(At, 0, 0); PG8_STAGE(PG8_SA(1, 1), a1 + hstep, voffA);
            PG8_WAIT_V(8); PG8_WAIT_L(0); PG8_BAR; PG8_MMA(0, 0, At, B0); PG8_MMA(0, 1, At, B1); PG8_BAR; PG8_SCHED;
            PG8_LDA(At, 0, 1); PG8_STAGE(PG8_SB(0, 0), b2, voffB); PG8_STAGE(PG8_SB(0, 1), b2 + hstep, voffB); PG8_STAGE(PG8_SA(0, 0), a2, voffA);
            PG8_WAIT_V(8); PG8_WAIT_L(0); PG8_BAR; PG8_MMA(1, 0, At, B0); PG8_MMA(1, 1, At, B1); PG8_BAR; PG8_SCHED;
            PG8_LDB(B0, 1, 0); PG8_LDB(B1, 1, 1); PG8_SCHED; PG8_LDA(At, 1, 0); PG8_STAGE(PG8_SA(0, 1), a2 + hstep, voffA);
            PG8_WAIT_V(8); PG8_WAIT_L(0); PG8_BAR; PG8_MMA(0, 0, At, B0); PG8_MMA(0, 1, At, B1); PG8_BAR; PG8_SCHED;
            PG8_LDA(At, 1, 1); PG8_STAGE(PG8_SB(1, 0), b3, voffB); PG8_STAGE(PG8_SB(1, 1), b3 + hstep, voffB); PG8_STAGE(PG8_SA(1, 0), a3, voffA);
            PG8_WAIT_V(8); PG8_WAIT_L(0); PG8_BAR; PG8_MMA(1, 0, At, B0); PG8_MMA(1, 1, At, B1); PG8_BAR; PG8_SCHED;
        }
        if (wr == 0) PG8_BAR;
        const bool keep = E(acc, cur, wr, wc, fr, fq, lds, tid);
        if (!has_next) break;
        if (!keep) {
#pragma unroll
            for (int a = 0; a < 2; ++a)
#pragma unroll
                for (int b = 0; b < 2; ++b)
#pragma unroll
                    for (int m = 0; m < 4; ++m)
#pragma unroll
                        for (int n = 0; n < 2; ++n) acc[a][b][m][n] = (f32x4){0.f, 0.f, 0.f, 0.f};
        }
        cur = nxt; cA = nA; cB = nB; ++ui;
        if (wr == 1) PG8_BAR;
    }
    PG8_WAIT_V(0);
    PG8_BAR;
#undef PG8_SA
#undef PG8_SB
#undef PG8_STAGE
#undef PG8_LDA
#undef PG8_LDB
#undef PG8_MMA
#undef PG8_WAIT_V
#undef PG8_WAIT_L
#undef PG8_SCHED
#undef PG8_UA
#undef PG8_UB
}
#define PG8_EPI_BARRIER() do { asm volatile("s_waitcnt lgkmcnt(0)" ::: "memory"); __builtin_amdgcn_s_barrier(); asm volatile("" ::: "memory"); } while (0)

template <int ACT> __device__ __forceinline__ u32x4 pack8(f32x4 v0, f32x4 v1, float sc) {
    float x[8] = {v0[0], v0[1], v0[2], v0[3], v1[0], v1[1], v1[2], v1[3]};
    u32x4 w;
    if (ACT == 2) {
        f16x8 h;
#pragma unroll
        for (int i = 0; i < 8; ++i) h[i] = (_Float16)sigmoidf_(x[i]);
        w = __builtin_bit_cast(u32x4, h);
    } else {
#pragma unroll
        for (int i = 0; i < 8; ++i) x[i] = (ACT == 1) ? x[i] * sigmoidf_(x[i]) : x[i] * sc;
        w.x = cvtpk(x[0], x[1]); w.y = cvtpk(x[2], x[3]); w.z = cvtpk(x[4], x[5]); w.w = cvtpk(x[6], x[7]);
    }
    return w;
}
template <int ACT> __device__ __forceinline__ void store_tile16(const Acc& acc, const Unit& u, int wr, int wc, int fr, int fq, bf16_t* base, int ld, int coff, float sc, const float* rstd) {
    const int row0 = u.pm * BM + wr * 64 + fr, col0 = coff + wc * 32 + 8 * fq;
#pragma unroll
    for (int ai = 0; ai < 2; ++ai)
#pragma unroll
        for (int m = 0; m < 4; ++m) { const int row = row0 + ai * HALF + m * 16; const float rs = rstd[row]; bf16_t* rowp = base + (size_t)row * ld + col0;
#pragma unroll
            for (int bj = 0; bj < 2; ++bj) *(u32x4*)(rowp + bj * HALF) = pack8<ACT>(acc[ai][bj][m][0] * rs, acc[ai][bj][m][1] * rs, sc); }
}
struct EpiIn {
    bf16_t *QA, *KA, *VA, *QB, *KB, *VB, *OG, *GA, *GB; float* GLOW; const float* rstd;
    __device__ __forceinline__ bool operator()(const Acc& acc, const Unit& u, int wr, int wc, int fr, int fq, LAS unsigned char*, int) const {
        const int pn = u.pn;
        if (pn < 4) store_tile16<0>(acc, u, wr, wc, fr, fq, QA, AQ, pn * 256, QA_SCALE, rstd);
        else if (pn == 4) store_tile16<0>(acc, u, wr, wc, fr, fq, KA, AKV, 0, 1.f, rstd);
        else if (pn == 5) store_tile16<0>(acc, u, wr, wc, fr, fq, VA, AKV, 0, 1.f, rstd);
        else if (pn < 8) store_tile16<0>(acc, u, wr, wc, fr, fq, QB, BQK, (pn - 6) * 256, 1.f, rstd);
        else if (pn < 10) store_tile16<0>(acc, u, wr, wc, fr, fq, KB, BQK, (pn - 8) * 256, 1.f, rstd);
        else if (pn < 14) store_tile16<0>(acc, u, wr, wc, fr, fq, VB, BV, (pn - 10) * 256, 1.f, rstd);
        else if (pn < 18) store_tile16<1>(acc, u, wr, wc, fr, fq, OG, BV, (pn - 14) * 256, 1.f, rstd);
        else if (pn < 26) store_tile16<2>(acc, u, wr, wc, fr, fq, GA, D, (pn - 18) * 256, 1.f, rstd);
        else if (pn < 34) store_tile16<2>(acc, u, wr, wc, fr, fq, GB, D, (pn - 26) * 256, 1.f, rstd);
        else if (wc == 0 && fq < 2) {
            const int row0 = u.pm * BM + wr * 64 + fr;
#pragma unroll
            for (int ai = 0; ai < 2; ++ai)
#pragma unroll
                for (int m = 0; m < 4; ++m) { const int row = row0 + ai * HALF + m * 16; const float rs = rstd[row]; float* p = GLOW + (size_t)row * RANK + 8 * fq;
                    *(f32x4*)p = acc[ai][0][m][0] * rs; *(f32x4*)(p + 4) = acc[ai][0][m][1] * rs; }
        }
        return false;
    }
};
struct EpiMerge {
    const _Float16 *GA, *GB; bf16_t* OUT;
    __device__ __forceinline__ bool operator()(Acc& acc, const Unit& u, int wr, int wc, int fr, int fq, LAS unsigned char*, int) const {
        const int row0 = u.pm * BM + wr * 64 + fr, col0 = u.pn * BM + wc * 32 + 8 * fq;
#pragma unroll
        for (int ai = 0; ai < 2; ++ai)
#pragma unroll
            for (int m = 0; m < 4; ++m) { const size_t off = (size_t)(row0 + ai * HALF + m * 16) * D + col0;
#pragma unroll
                for (int bj = 0; bj < 2; ++bj) {
                    const f16x8 gb = *(const f16x8*)(GB + off + bj * HALF);
                    if (u.seg == 0) {
                        const f16x8 ga = *(const f16x8*)(GA + off + bj * HALF);
#pragma unroll
                        for (int i = 0; i < 4; ++i) { acc[ai][bj][m][0][i] *= (float)ga[i] * __builtin_amdgcn_rcpf((float)gb[i]); acc[ai][bj][m][1][i] *= (float)ga[4 + i] * __builtin_amdgcn_rcpf((float)gb[4 + i]); }
                    } else {
                        f32x4 v0, v1;
#pragma unroll
                        for (int i = 0; i < 4; ++i) { v0[i] = acc[ai][bj][m][0][i] * (float)gb[i]; v1[i] = acc[ai][bj][m][1][i] * (float)gb[4 + i]; }
                        *(u32x4*)(OUT + off + bj * HALF) = pack8<0>(v0, v1, 1.f);
                    }
                } }
        return u.seg == 0;
    }
};
template <bool WITH_BF> struct EpiRes {
    const float* base; float* out; bf16_t* hb; float* stat;
    __device__ __forceinline__ bool operator()(const Acc& acc, const Unit& u, int wr, int wc, int fr, int fq, LAS unsigned char* lds, int tid) const {
        LAS float* XL = (LAS float*)(lds + XL_OFF);
        const int row0 = u.pm * BM + wr * 64 + fr, col0 = u.pn * BM + wc * 32 + 8 * fq;
#pragma unroll
        for (int ai = 0; ai < 2; ++ai)
#pragma unroll
            for (int m = 0; m < 4; ++m) { const int rl = ai * HALF + wr * 64 + m * 16 + fr; const size_t off = (size_t)(row0 + ai * HALF + m * 16) * D + col0; float ss = 0.f;
#pragma unroll
                for (int bj = 0; bj < 2; ++bj) {
                    const f32x4 b0 = *(const f32x4*)(base + off + bj * HALF), b1 = *(const f32x4*)(base + off + bj * HALF + 4);
                    const f32x4 h0 = b0 + acc[ai][bj][m][0], h1 = b1 + acc[ai][bj][m][1];
                    *(f32x4*)(out + off + bj * HALF) = h0; *(f32x4*)(out + off + bj * HALF + 4) = h1;
                    if (WITH_BF) *(u32x4*)(hb + off + bj * HALF) = pack8<0>(h0, h1, 1.f);
                    ss += (h0[0] * h0[0] + h0[1] * h0[1]) + (h0[2] * h0[2] + h0[3] * h0[3]) + (h1[0] * h1[0] + h1[1] * h1[1]) + (h1[2] * h1[2] + h1[3] * h1[3]);
                }
                ss += __shfl_xor(ss, 16); ss += __shfl_xor(ss, 32);
                if (fq == 0) XL[rl * 4 + wc] = ss; }
        PG8_EPI_BARRIER();
        if (tid < 256) { const f32x4 p = *(const LAS f32x4*)(XL + tid * 4); stat[(size_t)(u.pm * BM + tid) * 8 + u.pn] = (p[0] + p[1]) + (p[2] + p[3]); }
        PG8_EPI_BARRIER();
        return false;
    }
};
struct EpiGU {
    const float* stat; bf16_t* H;
    __device__ __forceinline__ bool operator()(const Acc& acc, const Unit& u, int wr, int wc, int fr, int fq, LAS unsigned char*, int) const {
        const int row0 = u.pm * BM + wr * 64 + fr, col0 = u.pn * HALF + wc * 32 + 8 * fq;
#pragma unroll
        for (int ai = 0; ai < 2; ++ai)
#pragma unroll
            for (int m = 0; m < 4; ++m) { const int row = row0 + ai * HALF + m * 16;
                const f32x4 s0 = *(const f32x4*)(stat + (size_t)row * 8), s1 = *(const f32x4*)(stat + (size_t)row * 8 + 4);
                const float rs = __builtin_amdgcn_rsqf(((s0[0] + s0[1]) + (s0[2] + s0[3]) + (s1[0] + s1[1]) + (s1[2] + s1[3])) * (1.f / D) + EPS);
                f32x4 v0, v1;
#pragma unroll
                for (int i = 0; i < 4; ++i) { const float g0 = acc[ai][0][m][0][i] * rs, g1 = acc[ai][0][m][1][i] * rs;
                    v0[i] = g0 * sigmoidf_(g0) * (acc[ai][1][m][0][i] * rs); v1[i] = g1 * sigmoidf_(g1) * (acc[ai][1][m][1][i] * rs); }
                *(u32x4*)(H + (size_t)row * FF + col0) = pack8<0>(v0, v1, 1.f); }
        return false;
    }
};
}

#define XB_TMO      128
#define XB_XCNT(j)  (256  + 64 * (j))
#define XB_XSUB(j)  (1280 + 64 * (j))
#define XB_XGEN(j)  (2304 + 64 * (j))
#define XB_TOP      3328
#define XB_TOPGEN   3392
#define XCD_BAR_WORDS 3456
#define XB_SPIN_CAP (1u << 18)
__device__ __forceinline__ unsigned xb_ld(unsigned* p)              { return __hip_atomic_load(p, __ATOMIC_RELAXED, __HIP_MEMORY_SCOPE_AGENT); }
__device__ __forceinline__ unsigned xb_add(unsigned* p, unsigned v) { return __hip_atomic_fetch_add(p, v, __ATOMIC_RELAXED, __HIP_MEMORY_SCOPE_AGENT); }
__device__ __forceinline__ unsigned xb_xcc_id() { return (unsigned)__builtin_amdgcn_s_getreg((3 << 11) | 20) & 0xFu; }
#define XB_SPIN(cond, bar) do { unsigned _sp = 0; while (cond) { __builtin_amdgcn_s_sleep(1); \
    if ((++_sp & 255u) == 0u) { if (xb_ld(&(bar)[XB_TMO])) break; if (_sp > XB_SPIN_CAP) { atomicAdd(&(bar)[XB_TMO], 1u); break; } } } } while (0)
struct XcdBarrier { unsigned* bar; unsigned x; volatile LAS unsigned* st; };
__device__ __forceinline__ XcdBarrier xcd_barrier_post(unsigned* bar, volatile LAS unsigned* st) {
    XcdBarrier b; b.bar = bar; b.x = xb_xcc_id(); b.st = st;
    if (threadIdx.x == 0) (void)xb_add(&bar[XB_XCNT(b.x)], 1u);
    return b;
}
__device__ __forceinline__ void xcd_barrier_complete(unsigned* bar, unsigned x, unsigned& nloc, unsigned& nx) {
    const unsigned G = gridDim.x * gridDim.y * gridDim.z;
    unsigned sum, cnt, mine, sp = 0u;
    for (;;) {
        sum = 0u; cnt = 0u; mine = 0u;
#pragma unroll
        for (unsigned j = 0; j < 16; ++j) { const unsigned c = xb_ld(&bar[XB_XCNT(j)]); sum += c; cnt += (c > 0u) ? 1u : 0u; mine = (j == x) ? c : mine; }
        if (sum == G) break;
        __builtin_amdgcn_s_sleep(1);
        if ((++sp & 255u) == 0u) { if (xb_ld(&bar[XB_TMO])) break; if (sp > XB_SPIN_CAP) { atomicAdd(&bar[XB_TMO], 1u); break; } }
    }
    nloc = mine > 0u ? mine : 1u; nx = cnt > 0u ? cnt : 1u;
}
__device__ __forceinline__ void xcd_barrier(const XcdBarrier& b) {
    asm volatile("s_waitcnt vmcnt(0)" ::: "memory");
    __syncthreads();
    if (threadIdx.x == 0) {
        unsigned* bar = b.bar;
        __builtin_amdgcn_s_waitcnt(0);
        unsigned nloc = b.st[0], nx = b.st[1];
        if (nloc == 0u) { xcd_barrier_complete(bar, b.x, nloc, nx); b.st[0] = nloc; b.st[1] = nx; }
        const unsigned old = xb_add(&bar[XB_XSUB(b.x)], 1u);
        const unsigned gen = old / nloc;
        if (old + 1u == (gen + 1u) * nloc) {
            __builtin_amdgcn_fence(__ATOMIC_RELEASE, "agent");
            asm volatile("s_waitcnt vmcnt(0)" ::: "memory");
            const unsigned og = xb_add(&bar[XB_TOP], 1u);
            const unsigned tg = og / nx;
            if (og + 1u == (tg + 1u) * nx) xb_add(&bar[XB_TOPGEN], 1u);
            else XB_SPIN(xb_ld(&bar[XB_TOPGEN]) == tg, bar);
            __builtin_amdgcn_fence(__ATOMIC_ACQUIRE, "agent");
            xb_add(&bar[XB_XGEN(b.x)], 1u);
            asm volatile("s_waitcnt vmcnt(0)" ::: "memory");
        } else {
            XB_SPIN(xb_ld(&bar[XB_XGEN(b.x)]) == gen, bar);
            __builtin_amdgcn_fence(__ATOMIC_ACQUIRE, "agent");
            asm volatile("s_waitcnt vmcnt(0)" ::: "memory");
        }
    }
    __syncthreads();
}

struct Args { const float* in[16]; float* out; unsigned char* ws; int ph_lo, ph_hi; };
struct Frame { LAS unsigned char* lds; int tid, lane, wave, G, bid; };

template <int MODE> __device__ __forceinline__ int dest_row(int n) {
    if (MODE == 1) return n < 3584 ? n : (n < 3600 ? 8704 + (n - 3584) : n - 16);
    if (MODE == 2) return 256 * (n >> 7) + (n & 127);
    if (MODE == 3) return 256 * (n >> 7) + 128 + (n & 127);
    return n;
}
template <int MODE> __device__ __forceinline__ void p0_transpose_item(const float* W, int K, int N, bf16_t* WT, const float* gk, LAS float* scr, int item, int lane) {
    const int nblk = (N + 31) / 32, kb = item / nblk, nb = item % nblk, k0 = 64 * kb, n0 = 32 * nb;
    const bool nok = (n0 + (lane & 31)) < N;
#pragma unroll 8
    for (int i = 0; i < 32; ++i) { const int kk = 2 * i + (lane >> 5); float v = nok ? W[(size_t)(k0 + kk) * N + n0 + (lane & 31)] : 0.f; if (gk) v *= gk[k0 + kk]; scr[kk * 33 + (lane & 31)] = v; }
    LDS_WAIT(); asm volatile("" ::: "memory");
    const int c = lane & 7;
#pragma unroll
    for (int j = 0; j < 4; ++j) { const int n = (lane >> 3) + 8 * j; const LAS float* s = scr + (8 * c) * 33 + n;
        u32x4 o; o.x = cvtpk(s[0 * 33], s[1 * 33]); o.y = cvtpk(s[2 * 33], s[3 * 33]); o.z = cvtpk(s[4 * 33], s[5 * 33]); o.w = cvtpk(s[6 * 33], s[7 * 33]);
        if (n0 + n < N) *(u32x4*)(WT + (size_t)dest_row<MODE>(n0 + n) * K + k0 + 8 * c) = o; }
    LDS_WAIT(); asm volatile("" ::: "memory");
}
__device__ __forceinline__ void p0_prologue(const Frame& F, const Args& a) {
    unsigned char* ws = a.ws;
    LAS float* scr = (LAS float*)(F.lds + F.wave * 16384);
    const int gw = F.bid * NWAVES + F.wave, NGW = F.G * NWAVES;
    constexpr int I_IN = (D / 64) * ((IN_W + 31) / 32), I_PA = (AQ / 64) * (D / 32), I_PB = (BV / 64) * (D / 32), I_WO = (D / 64) * (D / 32), I_G = (D / 64) * (FF / 32), I_D = (FF / 64) * (D / 32);
    constexpr int NITEMS = I_IN + I_PA + I_PB + I_WO + 2 * I_G + I_D;
    for (int it = gw; it < NITEMS; it += NGW) {
        int r = it;
        if (r < I_IN) { p0_transpose_item<1>(a.in[2], D, IN_W, (bf16_t*)(ws + WS_WIN), a.in[1], scr, r, F.lane); continue; } r -= I_IN;
        if (r < I_PA) { p0_transpose_item<0>(a.in[8], AQ, D, (bf16_t*)(ws + WS_PA), nullptr, scr, r, F.lane); continue; } r -= I_PA;
        if (r < I_PB) { p0_transpose_item<0>(a.in[9], BV, D, (bf16_t*)(ws + WS_PB), nullptr, scr, r, F.lane); continue; } r -= I_PB;
        if (r < I_WO) { p0_transpose_item<0>(a.in[10], D, D, (bf16_t*)(ws + WS_WOUT), nullptr, scr, r, F.lane); continue; } r -= I_WO;
        if (r < I_G) { p0_transpose_item<2>(a.in[12], D, FF, (bf16_t*)(ws + WS_WGU), a.in[11], scr, r, F.lane); continue; } r -= I_G;
        if (r < I_G) { p0_transpose_item<3>(a.in[13], D, FF, (bf16_t*)(ws + WS_WGU), a.in[11], scr, r, F.lane); continue; } r -= I_G;
        p0_transpose_item<0>(a.in[14], FF, D, (bf16_t*)(ws + WS_WD), nullptr, scr, r, F.lane);
    }
    { u32x4* z = (u32x4*)(ws + WS_WIN + (size_t)IN_W * D * 2); const int nz = (NIN - IN_W) * D * 2 / 16;
      for (int i = F.bid * 512 + F.tid; i < nz; i += F.G * 512) z[i] = (u32x4){0u, 0u, 0u, 0u}; }
    const float* x = a.in[0]; bf16_t* XB = (bf16_t*)(ws + WS_XB); float* RS = (float*)(ws + WS_RSTD1);
    for (int m = gw; m < M; m += NGW) {
        const f32x4* xr = (const f32x4*)(x + (size_t)m * D) + F.lane; f32x4 v[8]; float s = 0.f;
#pragma unroll
        for (int j = 0; j < 8; ++j) { v[j] = xr[64 * j]; s += (v[j][0] * v[j][0] + v[j][1] * v[j][1]) + (v[j][2] * v[j][2] + v[j][3] * v[j][3]); }
        s = wave_sum(s);
        u32x2* o = (u32x2*)(XB + (size_t)m * D) + F.lane;
#pragma unroll
        for (int j = 0; j < 8; ++j) o[64 * j] = (u32x2){cvtpk(v[j][0], v[j][1]), cvtpk(v[j][2], v[j][3])};
        if (F.lane == 0) RS[m] = __builtin_amdgcn_rsqf(s * (1.f / D) + EPS);
    }
}

__device__ __forceinline__ unsigned short elem16(const u32x4& v, int e) { const unsigned w = v[e >> 1]; return (unsigned short)((e & 1) ? (w >> 16) : (w & 0xffffu)); }
constexpr int SW_KS = 72, SW_VS = 264;
__device__ __forceinline__ void swa_unit(const Frame& F, const Args& a, int u) {
    const int b = u >> 7, blk = (u >> 2) & 31, kvh = u & 3;
    const int tid = F.tid, lane = F.lane, w = F.wave, l31 = lane & 31, hi = lane >> 5;
    unsigned char* ws = a.ws;
    bf16_t* QA = (bf16_t*)(ws + WS_QA); const bf16_t* KA = (const bf16_t*)(ws + WS_KA); const bf16_t* VA = (const bf16_t*)(ws + WS_VA);
    LAS bf16_t* Ks = (LAS bf16_t*)(F.lds);
    LAS bf16_t* VT = (LAS bf16_t*)(F.lds + 256 * SW_KS * 2);
    LAS float* BT = (LAS float*)(F.lds + 256 * SW_KS * 2 + 64 * SW_VS * 2);
    const long r0 = (long)b * SEQ + blk * 128;
#pragma unroll
    for (int i = 0; i < 4; ++i) { const int p = tid + 512 * i, row = p >> 3, ch = p & 7; const long grow = r0 - 128 + row;
        u32x4 kv = (u32x4){0u, 0u, 0u, 0u}, vv = (u32x4){0u, 0u, 0u, 0u};
        if (blk > 0 || row >= 128) { kv = *(const u32x4*)(KA + grow * AKV + kvh * 64 + ch * 8); vv = *(const u32x4*)(VA + grow * AKV + kvh * 64 + ch * 8); }
        *(LAS u32x4*)(Ks + row * SW_KS + ch * 8) = kv;
#pragma unroll
        for (int e = 0; e < 8; ++e) VT[(ch * 8 + e) * SW_VS + row] = elem16(vv, e); }
    { const int hq = tid >> 7, dist = tid & 127;
      int bucket = dist;
      if (dist >= 16) { bucket = 16 + (int)(__logf((float)dist * (1.f / 16.f)) * (16.f / 2.0794415416798357f)); bucket = bucket > 31 ? 31 : bucket; }
      BT[tid] = a.in[4][bucket * 16 + kvh * 4 + hq] * LOG2E; }
    __syncthreads();
    const int hq = w >> 1, head = kvh * 4 + hq;
    const float sinkv = a.in[3][head] * LOG2E;
#pragma unroll 1
    for (int qt = 0; qt < 2; ++qt) {
        const int i0 = 64 * (w & 1) + 32 * qt;
        bf16x8 qf[4];
#pragma unroll
        for (int ds = 0; ds < 4; ++ds) qf[ds] = *(const bf16x8*)(QA + (r0 + i0 + l31) * AQ + head * 64 + 16 * ds + 8 * hi);
        f32x16 p[5];
#pragma unroll
        for (int kt = 0; kt < 5; ++kt) { p[kt] = (f32x16){};
#pragma unroll
            for (int ds = 0; ds < 4; ++ds) { const bf16x8 kf = *(const LAS bf16x8*)(Ks + (i0 + 32 * kt + l31) * SW_KS + 16 * ds + 8 * hi);
                p[kt] = __builtin_amdgcn_mfma_f32_32x32x16_bf16(kf, qf[ds], p[kt], 0, 0, 0); } }
        const int q = i0 + l31; float mx = sinkv;
#pragma unroll
        for (int kt = 0; kt < 5; ++kt)
#pragma unroll
            for (int r = 0; r < 16; ++r) { const int j = i0 + 32 * kt + crow(r, hi), dist = q + 128 - j;
                const bool valid = dist >= 0 && dist < 128 && (blk > 0 || j >= 128);
                const float s = valid ? p[kt][r] + BT[hq * 128 + (dist & 127)] : -1e30f;
                p[kt][r] = s; mx = fmaxf(mx, s); }
        mx = fmaxf(mx, __shfl_xor(mx, 32));
        float sum = 0.f;
#pragma unroll
        for (int kt = 0; kt < 5; ++kt)
#pragma unroll
            for (int r = 0; r < 16; ++r) { const float e = __builtin_amdgcn_exp2f(p[kt][r] - mx); p[kt][r] = e; sum += e; }
        sum += __shfl_xor(sum, 32);
        sum += __builtin_amdgcn_exp2f(sinkv - mx);
        const float inv = 1.f / sum;
        f32x16 o[2]; o[0] = (f32x16){}; o[1] = (f32x16){};
#pragma unroll
        for (int kt = 0; kt < 5; ++kt)
#pragma unroll
            for (int s2 = 0; s2 < 2; ++s2) {
                u32x4 pw;
#pragma unroll
                for (int i = 0; i < 4; ++i) pw[i] = cvtpk(p[kt][8 * s2 + 2 * i] * inv, p[kt][8 * s2 + 2 * i + 1] * inv);
                const bf16x8 pa = __builtin_bit_cast(bf16x8, pw);
#pragma unroll
                for (int dh = 0; dh < 2; ++dh) { const LAS bf16_t* vp = VT + (32 * dh + l31) * SW_VS + i0 + 32 * kt + 16 * s2 + 4 * hi;
                    const s16x4 lo = *(const LAS s16x4*)vp, hi4 = *(const LAS s16x4*)(vp + 8);
                    const bf16x8 vb = (bf16x8){lo[0], lo[1], lo[2], lo[3], hi4[0], hi4[1], hi4[2], hi4[3]};
                    o[dh] = __builtin_amdgcn_mfma_f32_32x32x16_bf16(pa, vb, o[dh], 0, 0, 0); } }
#pragma unroll
        for (int dh = 0; dh < 2; ++dh)
#pragma unroll
            for (int r = 0; r < 16; ++r) QA[(r0 + i0 + crow(r, hi)) * AQ + head * 64 + 32 * dh + l31] = f2bf(o[dh][r]);
    }
    __syncthreads();
}

constexpr int GL_S = 72;
__device__ __forceinline__ void gla_stage_vt(const Frame& F, const bf16_t* VB, long t0, int h, LAS bf16_t* VT) {
#pragma unroll
    for (int i = 0; i < 4; ++i) { const int p = F.tid + 512 * i, s = p >> 5, ch = p & 31;
        const u32x4 vv = *(const u32x4*)(VB + (t0 + s) * BV + h * 256 + ch * 8);
#pragma unroll
        for (int e = 0; e < 8; ++e) VT[(ch * 8 + e) * GL_S + s] = elem16(vv, e); }
}
__device__ __forceinline__ void gla_a_unit(const Frame& F, const Args& a, int u) {
    const int b = u >> 8, h = (u >> 6) & 3, c = u & 63;
    const int tid = F.tid, lane = F.lane, w = F.wave, l31 = lane & 31, hi = lane >> 5;
    unsigned char* ws = a.ws;
    bf16_t* QB = (bf16_t*)(ws + WS_QB); bf16_t* KB = (bf16_t*)(ws + WS_KB); const bf16_t* VB = (const bf16_t*)(ws + WS_VB);
    const float* GLOW = (const float*)(ws + WS_GLOW); float* DEC = (float*)(ws + WS_DEC); bf16_t* ST = (bf16_t*)(ws + WS_STATE) + (size_t)u * 32768;
    LAS float* GL = (LAS float*)F.lds;
    LAS float* TOT = (LAS float*)(F.lds + 4096);
    LAS bf16_t* KsT = (LAS bf16_t*)(F.lds + 8192);
    LAS bf16_t* VT = (LAS bf16_t*)(F.lds + 8192 + 128 * GL_S * 2);
    const long t0 = (long)b * SEQ + 64 * c;
    if (tid < 256) *(LAS f32x4*)(GL + tid * 4) = *(const f32x4*)(GLOW + (size_t)t0 * RANK + tid * 4);
    gla_stage_vt(F, VB, t0, h, VT);
    const int d = tid & 127, sg = tid >> 7;
    float wg[16];
#pragma unroll
    for (int r = 0; r < 16; ++r) wg[r] = a.in[5][r * BQK + h * 128 + d];
    const float bg = a.in[6][h * 128 + d];
    __syncthreads();
    float bl[16]; float run = 0.f;
#pragma unroll
    for (int i = 0; i < 16; ++i) { const int s = sg * 16 + i; float G = bg;
#pragma unroll
        for (int r4 = 0; r4 < 4; ++r4) { const f32x4 gv = *(const LAS f32x4*)(GL + s * 16 + r4 * 4); G += gv[0] * wg[4 * r4] + gv[1] * wg[4 * r4 + 1] + gv[2] * wg[4 * r4 + 2] + gv[3] * wg[4 * r4 + 3]; }
        const float ls = fminf(G, 0.f) - __logf(1.f + __expf(-fabsf(G)));
        run += ls * (1.f / 16.f); bl[i] = run; }
    TOT[sg * 128 + d] = run;
    __syncthreads();
    float off = 0.f, tot = 0.f;
#pragma unroll
    for (int g = 0; g < 4; ++g) { const float t = TOT[g * 128 + d]; if (g < sg) off += t; tot += t; }
#pragma unroll
    for (int i = 0; i < 16; ++i) { const int s = sg * 16 + i; const float bb = off + bl[i]; const size_t gi = (size_t)(t0 + s) * BQK + h * 128 + d;
        const float qv = bf2f(QB[gi]), kv = bf2f(KB[gi]);
        QB[gi] = f2bf(qv * __expf(bb) * QB_SCALE); KB[gi] = f2bf(kv * __expf(-bb)); KsT[d * GL_S + s] = f2bf(kv * __expf(tot - bb)); }
    if (sg == 0) DEC[u * 128 + d] = __expf(tot);
    __syncthreads();
    bf16x8 af[4];
#pragma unroll
    for (int st = 0; st < 4; ++st) af[st] = *(const LAS bf16x8*)(VT + (32 * w + l31) * GL_S + 16 * st + 8 * hi);
#pragma unroll
    for (int dt = 0; dt < 4; ++dt) { f32x16 acc = (f32x16){};
#pragma unroll
        for (int st = 0; st < 4; ++st) { const bf16x8 bfr = *(const LAS bf16x8*)(KsT + (32 * dt + l31) * GL_S + 16 * st + 8 * hi); acc = __builtin_amdgcn_mfma_f32_32x32x16_bf16(af[st], bfr, acc, 0, 0, 0); }
#pragma unroll
        for (int r = 0; r < 16; ++r) ST[(32 * w + crow(r, hi)) * 128 + 32 * dt + l31] = f2bf(acc[r]); }
    __syncthreads();
}

__device__ __forceinline__ void gla_scan(const Frame& F, const Args& a) {
    unsigned char* ws = a.ws; unsigned* ST = (unsigned*)(ws + WS_STATE); const float* DEC = (const float*)(ws + WS_DEC);
    for (int idx = F.bid * 512 + F.tid; idx < 8 * 16384; idx += F.G * 512) {
        const int bh = idx >> 14, e2 = idx & 16383, d0 = (e2 * 2) & 127;
        unsigned* p = ST + (size_t)bh * 64 * 16384 + e2; const float* dp = DEC + (size_t)bh * 64 * 128 + d0;
        float s0 = 0.f, s1 = 0.f;
#pragma unroll 8
        for (int c = 0; c < 64; ++c) { const unsigned x = p[(size_t)c * 16384]; const f32x2 dc = *(const f32x2*)(dp + c * 128);
            p[(size_t)c * 16384] = cvtpk(s0, s1); s0 = dc[0] * s0 + bflo(x); s1 = dc[1] * s1 + bfhi(x); }
    }
}

constexpr int OS_S = 260;
__device__ __forceinline__ void gla_c_unit(const Frame& F, const Args& a, int u) {
    const int b = u >> 8, h = (u >> 6) & 3, c = u & 63;
    const int lane = F.lane, w = F.wave, l31 = lane & 31, hi = lane >> 5;
    unsigned char* ws = a.ws;
    const bf16_t* QB = (const bf16_t*)(ws + WS_QB); const bf16_t* KB = (const bf16_t*)(ws + WS_KB); bf16_t* VB = (bf16_t*)(ws + WS_VB);
    const bf16_t* OG = (const bf16_t*)(ws + WS_OG); const bf16_t* ST = (const bf16_t*)(ws + WS_STATE) + (size_t)u * 32768;
    LAS bf16_t* VT = (LAS bf16_t*)F.lds;
    LAS float* OS = (LAS float*)(F.lds + 256 * GL_S * 2);
    const long t0 = (long)b * SEQ + 64 * c;
    gla_stage_vt(F, VB, t0, h, VT);
    const int ct = w & 1, vt0 = (w >> 1) * 2;
    bf16x8 qf[8];
#pragma unroll
    for (int st = 0; st < 8; ++st) qf[st] = *(const bf16x8*)(QB + (t0 + 32 * ct + l31) * BQK + h * 128 + 16 * st + 8 * hi);
    f32x16 aT[2];
#pragma unroll
    for (int sti = 0; sti < 2; ++sti) { aT[sti] = (f32x16){};
        if (sti <= ct) {
#pragma unroll
            for (int st = 0; st < 8; ++st) { const bf16x8 kf = *(const bf16x8*)(KB + (t0 + 32 * sti + l31) * BQK + h * 128 + 16 * st + 8 * hi);
                aT[sti] = __builtin_amdgcn_mfma_f32_32x32x16_bf16(kf, qf[st], aT[sti], 0, 0, 0); }
#pragma unroll
            for (int r = 0; r < 16; ++r) if (32 * sti + crow(r, hi) > 32 * ct + l31) aT[sti][r] = 0.f;
        } }
    __syncthreads();
    f32x16 o[2];
#pragma unroll
    for (int j = 0; j < 2; ++j) { o[j] = (f32x16){};
        const int vrow = 32 * (vt0 + j) + l31;
#pragma unroll
        for (int st = 0; st < 8; ++st) { const bf16x8 sf = *(const bf16x8*)(ST + vrow * 128 + 16 * st + 8 * hi); o[j] = __builtin_amdgcn_mfma_f32_32x32x16_bf16(qf[st], sf, o[j], 0, 0, 0); }
#pragma unroll
        for (int sti = 0; sti < 2; ++sti) if (sti <= ct) {
#pragma unroll
            for (int s2 = 0; s2 < 2; ++s2) { u32x4 pw;
#pragma unroll
                for (int i = 0; i < 4; ++i) pw[i] = cvtpk(aT[sti][8 * s2 + 2 * i], aT[sti][8 * s2 + 2 * i + 1]);
                const LAS bf16_t* vp = VT + vrow * GL_S + 32 * sti + 16 * s2 + 4 * hi;
                const s16x4 lo = *(const LAS s16x4*)vp, hi4 = *(const LAS s16x4*)(vp + 8);
                const bf16x8 vb = (bf16x8){lo[0], lo[1], lo[2], lo[3], hi4[0], hi4[1], hi4[2], hi4[3]};
                o[j] = __builtin_amdgcn_mfma_f32_32x32x16_bf16(__builtin_bit_cast(bf16x8, pw), vb, o[j], 0, 0, 0); } }
#pragma unroll
        for (int r = 0; r < 16; ++r) OS[(32 * ct + crow(r, hi)) * OS_S + 32 * (vt0 + j) + l31] = o[j][r]; }
    __syncthreads();
    const f32x4 gn = *(const f32x4*)(a.in[7] + 4 * lane);
#pragma unroll
    for (int i = 0; i < 8; ++i) { const int row = 8 * w + i; const f32x4 v = *(const LAS f32x4*)(OS + row * OS_S + 4 * lane);
        const float ss = wave_sum((v[0] * v[0] + v[1] * v[1]) + (v[2] * v[2] + v[3] * v[3]));
        const float rs = __builtin_amdgcn_rsqf(ss * (1.f / 256.f) + EPS);
        const size_t gi = (size_t)(t0 + row) * BV + h * 256 + 4 * lane; const u32x2 og = *(const u32x2*)(OG + gi);
        *(u32x2*)(VB + gi) = (u32x2){cvtpk(v[0] * rs * gn[0] * bflo(og[0]), v[1] * rs * gn[1] * bfhi(og[0])), cvtpk(v[2] * rs * gn[2] * bflo(og[1]), v[3] * rs * gn[3] * bfhi(og[1]))}; }
    __syncthreads();
}

__device__ __forceinline__ void final_norm(const Frame& F, const Args& a) {
    const float* stat = (const float*)(a.ws + WS_STAT3); const float* gf = a.in[15];
    const int gw = F.bid * NWAVES + F.wave, NGW = F.G * NWAVES;
    for (int m = gw; m < M; m += NGW) {
        const f32x4 s0 = *(const f32x4*)(stat + (size_t)m * 8), s1 = *(const f32x4*)(stat + (size_t)m * 8 + 4);
        const float rs = __builtin_amdgcn_rsqf(((s0[0] + s0[1]) + (s0[2] + s0[3]) + (s1[0] + s1[1]) + (s1[2] + s1[3])) * (1.f / D) + EPS);
        f32x4* xr = (f32x4*)(a.out + (size_t)m * D) + F.lane; const f32x4* gr = (const f32x4*)gf + F.lane;
#pragma unroll
        for (int j = 0; j < 8; ++j) xr[64 * j] = xr[64 * j] * rs * gr[64 * j];
    }
}

constexpr int N_PHASES = 10;
__global__ void __launch_bounds__(NWAVES * 64, 2) fwd_kernel(Args args) {
    extern __shared__ __attribute__((aligned(16))) unsigned char lds_raw[];
    Frame F;
    F.lds = (LAS unsigned char*)lds_raw;
    F.tid = threadIdx.x; F.lane = F.tid & 63; F.wave = __builtin_amdgcn_readfirstlane(F.tid >> 6);
    F.G = gridDim.x; F.bid = blockIdx.x;
    unsigned char* ws = args.ws;
    const int lo = args.ph_lo, hi = args.ph_hi;
#define IN(k) (lo <= (k) && (k) < hi)
#define SEAM(k) do { if (IN(k) && IN((k) + 1)) xcd_barrier(bar); } while (0)
    volatile LAS unsigned* MISC = (volatile LAS unsigned*)(F.lds + RING_BYTES);
    if (F.tid < 16) MISC[F.tid] = 0u;
    __syncthreads();
    XcdBarrier bar = xcd_barrier_post((unsigned*)(ws + WS_BAR), MISC + 8);

    if (IN(0)) { p0_prologue(F, args); } SEAM(0);

    if (IN(1)) {
        pg8::Gemm g{(const bf16_t*)(ws + WS_XB), nullptr, (const bf16_t*)(ws + WS_WIN), nullptr, D};
        pg8::StaticOrder S; S.init(M, NIN, F.G, F.bid, 0);
        pg8::EpiIn E{(bf16_t*)(ws + WS_QA), (bf16_t*)(ws + WS_KA), (bf16_t*)(ws + WS_VA), (bf16_t*)(ws + WS_QB), (bf16_t*)(ws + WS_KB), (bf16_t*)(ws + WS_VB), (bf16_t*)(ws + WS_OG),
                     (bf16_t*)(ws + WS_GA), (bf16_t*)(ws + WS_GB), (float*)(ws + WS_GLOW), (const float*)(ws + WS_RSTD1)};
        pg8::gemm_phase(F.lds, g, S, E);
    } SEAM(1);

    if (IN(2)) {
        for (int u = F.bid; u < 256; u += F.G) swa_unit(F, args, u);
        for (int u = F.bid; u < 512; u += F.G) gla_a_unit(F, args, u);
    } SEAM(2);

    if (IN(3)) { gla_scan(F, args); } SEAM(3);

    if (IN(4)) { for (int u = F.bid; u < 512; u += F.G) gla_c_unit(F, args, u); } SEAM(4);

    if (IN(5)) {
        pg8::Gemm g{(const bf16_t*)(ws + WS_QA), (const bf16_t*)(ws + WS_VB), (const bf16_t*)(ws + WS_PA), (const bf16_t*)(ws + WS_PB), AQ};
        pg8::StaticOrder S; S.init(M, D, F.G, F.bid, 1);
        pg8::EpiMerge E{(const _Float16*)(ws + WS_GA), (const _Float16*)(ws + WS_GB), (bf16_t*)(ws + WS_MERGED)};
        pg8::gemm_phase(F.lds, g, S, E);
    } SEAM(5);

    if (IN(6)) {
        pg8::Gemm g{(const bf16_t*)(ws + WS_MERGED), nullptr, (const bf16_t*)(ws + WS_WOUT), nullptr, D};
        pg8::StaticOrder S; S.init(M, D, F.G, F.bid, 0);
        pg8::EpiRes<true> E{args.in[0], args.out, (bf16_t*)(ws + WS_HB), (float*)(ws + WS_STAT2)};
        pg8::gemm_phase(F.lds, g, S, E);
    } SEAM(6);

    if (IN(7)) {
        pg8::Gemm g{(const bf16_t*)(ws + WS_HB), nullptr, (const bf16_t*)(ws + WS_WGU), nullptr, D};
        pg8::StaticOrder S; S.init(M, 2 * FF, F.G, F.bid, 0);
        pg8::EpiGU E{(const float*)(ws + WS_STAT2), (bf16_t*)(ws + WS_H)};
        pg8::gemm_phase(F.lds, g, S, E);
    } SEAM(7);

    if (IN(8)) {
        pg8::Gemm g{(const bf16_t*)(ws + WS_H), nullptr, (const bf16_t*)(ws + WS_WD), nullptr, FF};
        pg8::StaticOrder S; S.init(M, D, F.G, F.bid, 0);
        pg8::EpiRes<false> E{args.out, args.out, nullptr, (float*)(ws + WS_STAT3)};
        pg8::gemm_phase(F.lds, g, S, E);
    } SEAM(8);

    if (IN(9)) { final_norm(F, args); }
#undef IN
#undef SEAM
}

extern "C" void kernel_launch(void* const* d_in, const int* in_sizes, int n_in, void* d_out, int out_size, void* d_ws, size_t ws_size, hipStream_t stream) {
    static int grid = 0;
    if (grid == 0) {
        if (n_in != 16 || in_sizes[0] != M * D || out_size != M * D || ws_size < WS_END) { fprintf(stderr, "kernel_launch: unexpected shapes (n_in %d, in0 %d, out %d, ws %zu); nothing launched\n", n_in, n_in > 0 ? in_sizes[0] : -1, out_size, ws_size); grid = -1; return; }
        int dev = 0, cus = 0, per_cu = 0;
        if (hipGetDevice(&dev) != hipSuccess || hipDeviceGetAttribute(&cus, hipDeviceAttributeMultiprocessorCount, dev) != hipSuccess) { grid = -1; return; }
        if (hipFuncSetAttribute((const void*)fwd_kernel, hipFuncAttributeMaxDynamicSharedMemorySize, LDS_BYTES) != hipSuccess) { fprintf(stderr, "kernel_launch: hipFuncSetAttribute failed\n"); grid = -1; return; }
        if (hipOccupancyMaxActiveBlocksPerMultiprocessor(&per_cu, (const void*)fwd_kernel, NWAVES * 64, LDS_BYTES) != hipSuccess || per_cu < 1) { fprintf(stderr, "kernel_launch: occupancy query failed (%d)\n", per_cu); (void)hipGetLastError(); per_cu = 1; }
        if (per_cu > 1) per_cu = 1;
        grid = cus * per_cu;
    }
    if (grid < 0) return;
    if (hipMemsetAsync((char*)d_ws + WS_BAR, 0, 16384, stream) != hipSuccess) { fprintf(stderr, "kernel_launch: memset failed\n"); return; }
    Args a{};
    for (int i = 0; i < 16; ++i) a.in[i] = (const float*)d_in[i];
    a.out = (float*)d_out; a.ws = (unsigned char*)d_ws;
#if MK_N_LAUNCHES == 1
    a.ph_lo = 0; a.ph_hi = N_PHASES;
    void* kargs[] = {&a};
    hipError_t e = hipLaunchCooperativeKernel((const void*)fwd_kernel, dim3(grid), dim3(NWAVES * 64), kargs, LDS_BYTES, stream);
    if (e != hipSuccess) fprintf(stderr, "kernel_launch: cooperative launch failed: %s (grid %d)\n", hipGetErrorString(e), grid);
#else
    for (int ph = 0; ph < N_PHASES; ++ph) { a.ph_lo = ph; a.ph_hi = ph + 1; hipLaunchKernelGGL(fwd_kernel, dim3(grid), dim3(NWAVES * 64), LDS_BYTES, stream, a); }
#endif
}
```

```cpp
#include <hip/hip_runtime.h>
#include <cstdio>
#include <cstdint>
#include <utility>

#ifndef MK_N_LAUNCHES
#define MK_N_LAUNCHES 1
#endif

#define LAS __attribute__((address_space(3)))
typedef unsigned short bf16_t;
typedef short bf16x8 __attribute__((ext_vector_type(8)));
typedef short s16x4 __attribute__((ext_vector_type(4)));
typedef float f32x4 __attribute__((ext_vector_type(4)));
typedef float f32x2 __attribute__((ext_vector_type(2)));
typedef float f32x16 __attribute__((ext_vector_type(16)));
typedef unsigned u32x4 __attribute__((ext_vector_type(4)));
typedef unsigned u32x2 __attribute__((ext_vector_type(2)));
typedef _Float16 f16x8 __attribute__((ext_vector_type(8)));
typedef __bf16 bf16x2_t __attribute__((ext_vector_type(2)));

constexpr int BATCH = 2, SEQ = 4096, M = BATCH * SEQ, D = 2048;
constexpr int IN_W = 8720, NIN = 8960;
constexpr int AQ = 1024, AKV = 256, BQK = 512, BV = 1024, RANK = 16, FF = 5632;
constexpr float EPS = 1e-6f, LOG2E = 1.4426950408889634f;
constexpr float QA_SCALE = 0.125f * LOG2E;
constexpr float QB_SCALE = 0.08838834764831845f;

constexpr size_t MiB = 1u << 20;
constexpr size_t WS_BAR = 0;
constexpr size_t WS_RSTD1 = 64 * 1024;
constexpr size_t WS_STAT2 = 128 * 1024;
constexpr size_t WS_STAT3 = 384 * 1024;
constexpr size_t WS_DEC = 640 * 1024;
constexpr size_t WS_GLOW = 1 * MiB;
constexpr size_t WS_PA = 4 * MiB, WS_PB = 8 * MiB, WS_WOUT = 12 * MiB, WS_WGU = 20 * MiB, WS_WD = 64 * MiB;
constexpr size_t WS_WIN = 86 * MiB, WS_XB = 121 * MiB;
constexpr size_t WS_STATE = 86 * MiB;
constexpr size_t WS_MERGED = 118 * MiB;
constexpr size_t WS_HB = 86 * MiB;
constexpr size_t WS_QA = 153 * MiB, WS_KA = 169 * MiB, WS_VA = 173 * MiB, WS_QB = 177 * MiB, WS_KB = 185 * MiB, WS_VB = 193 * MiB, WS_OG = 209 * MiB, WS_GA = 225 * MiB, WS_GB = 257 * MiB;
constexpr size_t WS_H = 153 * MiB;
constexpr size_t WS_END = 289 * MiB;

constexpr int RING_BYTES = 131072;
constexpr int CTL_OFF = 139264;
constexpr int XL_OFF = CTL_OFF + 1024;
constexpr int CV_S = 65, CV_BYTES = 64 * CV_S * 4;
constexpr int LDS_BYTES = 147456;
constexpr int NWAVES = 8;

__device__ __forceinline__ unsigned cvtpk(float lo, float hi) { f32x2 v = {lo, hi}; bf16x2_t b = __builtin_convertvector(v, bf16x2_t); return __builtin_bit_cast(unsigned, b); }
__device__ __forceinline__ bf16_t f2bf(float f) { return (bf16_t)(cvtpk(f, 0.f) & 0xffffu); }
__device__ __forceinline__ float bf2f(bf16_t b) { return __builtin_bit_cast(float, (unsigned)b << 16); }
__device__ __forceinline__ float bflo(unsigned w) { return __builtin_bit_cast(float, w << 16); }
__device__ __forceinline__ float bfhi(unsigned w) { return __builtin_bit_cast(float, w & 0xffff0000u); }
__device__ __forceinline__ float sigmoidf_(float v) { return __builtin_amdgcn_rcpf(1.f + __builtin_amdgcn_exp2f(-v * LOG2E)); }
__device__ __forceinline__ float wave_sum(float v) {
#pragma unroll
    for (int o = 1; o < 64; o <<= 1) v += __shfl_xor(v, o);
    return v;
}
__device__ __forceinline__ int crow(int r, int hi) { return (r & 3) + 8 * (r >> 2) + 4 * hi; }
#define LDS_WAIT() asm volatile("s_waitcnt lgkmcnt(0)" ::: "memory")
#define VM_WAIT() asm volatile("s_waitcnt vmcnt(0)" ::: "memory")

namespace pg8 {
constexpr int BM = 256, BK = 64, HALF = 128, HTB = HALF * BK * 2, NXCD = 8, WGM = 8;
__host__ __device__ __forceinline__ int lds_byte(int r, int c) { const int st = (r >> 4) * 2 + (c >> 5), rr = r & 15, cc = c & 31, ob = rr * 64 + cc * 2; return st * 1024 + (ob ^ (((ob >> 9) & 1) << 5)); }
__host__ __device__ __forceinline__ void stage_rc(int b, int& R, int& C) { const int st = b / 1024, sb = b % 1024, swz = sb ^ (((sb >> 9) & 1) << 5); R = (st >> 1) * 16 + swz / 64; C = (st & 1) * 32 + (swz % 64) / 2; }
__host__ __device__ __forceinline__ int perm32(int rho) { const int n = rho >> 4, i = rho & 15; return 8 * (i >> 2) + 4 * n + (i & 3); }

struct Unit { int pm, pn, seg; };
struct Gemm { const bf16_t* A0; const bf16_t* A1; const bf16_t* B0; const bf16_t* B1; int K; };

struct StaticOrder {
    int nM, nN, nwg, G, c, two;
    __device__ void init(int M_, int N_, int G_, int c_, int two_) { nM = M_ / BM; nN = N_ / BM; nwg = nM * nN; G = G_; c = c_; two = two_; }
    __device__ bool next(int i, Unit& u) const {
        const int ti = two ? (i >> 1) : i; u.seg = two ? (i & 1) : 0;
        const long L = (long)ti * G + c; if (L >= nwg) return false;
        int wgid = (int)L; { const int q = nwg / NXCD, r = nwg % NXCD, xcd = wgid % NXCD, off = wgid / NXCD; wgid = (xcd < r ? xcd * (q + 1) : r * (q + 1) + (xcd - r) * q) + off; }
        const int nig = WGM * nN, gid = wgid / nig, fm = gid * WGM, gsz = (nM - fm) < WGM ? (nM - fm) : WGM;
        u.pm = fm + ((wgid % nig) % gsz); u.pn = (wgid % nig) / gsz; return true;
    }
};

typedef f32x4 Acc[2][2][4][2];

template <class Epi, class Sched>
__device__ __forceinline__ void gemm_phase(LAS unsigned char* lds, const Gemm g, const Sched& S, const Epi& E) {
    const int tid = threadIdx.x, wid = __builtin_amdgcn_readfirstlane(tid >> 6), lane = tid & 63, wr = wid >> 2, wc = wid & 3, fr = lane & 15, fq = lane >> 4;
    const int K = g.K, nt = K / BK;
    unsigned voffA[2], voffB[2];
#pragma unroll
    for (int i = 0; i < 2; ++i) { int R, C; stage_rc(tid * 16 + i * 8192, R, C); const int Rb = (R & ~31) + perm32(R & 31);
        voffA[i] = (unsigned)(R * K + C) * 2u; voffB[i] = (unsigned)(Rb * K + C) * 2u; }
    const size_t kstep = (size_t)(BK * 2);
    const size_t hstep = (size_t)HALF * K * 2;
    const size_t tstep = 2 * hstep;
    const unsigned ldsw = (unsigned)wid * 1024u;
    const int aoff = lds_byte(wr * 64 + fr, fq * 8), boff = lds_byte(wc * 32 + fr, fq * 8);
#define PG8_SA(b, h) (((b) * 2 + (h)) * HTB)
#define PG8_SB(b, h) ((4 + (b) * 2 + (h)) * HTB)
#define PG8_STAGE(bufoff, gbase, voff) do { _Pragma("unroll") for (int _i = 0; _i < 2; ++_i) \
        __builtin_amdgcn_global_load_lds((const unsigned*)((const char*)(gbase) + (voff)[_i]), (LAS unsigned*)(lds + (bufoff) + ldsw + _i * 8192), 16, 0, 0); } while (0)
#define PG8_LDA(dst, b, h) do { _Pragma("unroll") for (int m = 0; m < 4; ++m) _Pragma("unroll") for (int k = 0; k < 2; ++k) dst[m][k] = *(const LAS bf16x8*)(lds + PG8_SA(b, h) + aoff + m * 2048 + k * 1024); } while (0)
#define PG8_LDB(dst, b, h) do { _Pragma("unroll") for (int n = 0; n < 2; ++n) _Pragma("unroll") for (int k = 0; k < 2; ++k) dst[n][k] = *(const LAS bf16x8*)(lds + PG8_SB(b, h) + boff + n * 2048 + k * 1024); } while (0)
#define PG8_MMA(ai, bj, At, Bt) do { __builtin_amdgcn_s_setprio(1); _Pragma("unroll") for (int m = 0; m < 4; ++m) _Pragma("unroll") for (int n = 0; n < 2; ++n) _Pragma("unroll") for (int k = 0; k < 2; ++k) \
        acc[ai][bj][m][n] = __builtin_amdgcn_mfma_f32_16x16x32_bf16(Bt[n][k], At[m][k], acc[ai][bj][m][n], 0, 0, 0); __builtin_amdgcn_s_setprio(0); } while (0)
#define PG8_WAIT_V(n) asm volatile("s_waitcnt vmcnt(" #n ")" ::: "memory")
#define PG8_WAIT_L(n) asm volatile("s_waitcnt lgkmcnt(" #n ")" ::: "memory")
#define PG8_BAR __builtin_amdgcn_s_barrier()
#define PG8_SCHED __builtin_amdgcn_sched_barrier(0)
#define PG8_UA(u) ((const char*)((u).seg ? g.A1 : g.A0) + (size_t)(u).pm * tstep)
#define PG8_UB(u) ((const char*)((u).seg ? g.B1 : g.B0) + (size_t)(u).pn * tstep)
    Unit cur, nxt; int ui = 0;
    if (!S.next(0, cur)) return;
    Acc acc;
#pragma unroll
    for (int a = 0; a < 2; ++a)
#pragma unroll
        for (int b = 0; b < 2; ++b)
#pragma unroll
            for (int m = 0; m < 4; ++m)
#pragma unroll
                for (int n = 0; n < 2; ++n) acc[a][b][m][n] = (f32x4){0.f, 0.f, 0.f, 0.f};
    bf16x8 At[4][2], B0[2][2], B1[2][2];
    const char* cA = PG8_UA(cur); const char* cB = PG8_UB(cur);
    PG8_STAGE(PG8_SB(0, 0), cB, voffB); PG8_STAGE(PG8_SB(0, 1), cB + hstep, voffB); PG8_STAGE(PG8_SA(0, 0), cA, voffA); PG8_STAGE(PG8_SA(0, 1), cA + hstep, voffA);
    if (wr == 1) PG8_BAR;
    PG8_WAIT_V(2); PG8_BAR;
    PG8_STAGE(PG8_SB(1, 0), cB + kstep, voffB); PG8_STAGE(PG8_SA(1, 0), cA + kstep, voffA); PG8_STAGE(PG8_SB(1, 1), cB + hstep + kstep, voffB);
    PG8_WAIT_V(6); PG8_BAR;
    for (;;) {
        const bool has_next = S.next(ui + 1, nxt);
        const char* nA = has_next ? PG8_UA(nxt) : cA; const char* nB = has_next ? PG8_UB(nxt) : cB;
        for (int t = 0; t < nt; t += 2) {
            const bool last = (t == nt - 2);
            const char* a1 = cA + (size_t)(t + 1) * kstep;
            const char* a2 = last ? nA : cA + (size_t)(t + 2) * kstep; const char* b2 = last ? nB : cB + (size_t)(t + 2) * kstep;
            const char* a3 = a2 + kstep; const char* b3 = b2 + kstep;
            PG8_LDB(B0, 0, 0); PG8_LDB(B1, 0, 1); PG8_SCHED; PG8_LDA(At, 0, 0); PG8_STAGE(PG8_SA(1, 1), a1 + hstep, voffA);
            PG8_WAIT_V(8); PG8_WAIT_L(0); PG8_BAR; PG8_MMA(0, 0, At, B0); PG8_MMA(0, 1, At, B1); PG8_BAR; PG8_SCHED;
            PG8_LDA(At, 0, 1); PG8_STAGE(PG8_SB(0, 0), b2, voffB); PG8_STAGE(PG8_SB(0, 1), b2 + hstep, voffB); PG8_STAGE(PG8_SA(0, 0), a2, voffA);
            PG8_WAIT_V(8); PG8_WAIT_L(0); PG8_BAR; PG8_MMA(1, 0, At, B0); PG8_MMA(1, 1, At, B1); PG8_BAR; PG8_SCHED;
            PG8_LDB(B0, 1, 0); PG8_LDB(B1, 1, 1); PG8_SCHED; PG8_LDA(At, 1, 0); PG8_STAGE(PG8_SA(0, 1), a2 + hstep, voffA);
            PG8_WAIT_V(8); PG8_WAIT_L(0); PG8_BAR; PG8_MMA(0, 0, At, B0); PG8_MMA(0, 1, At, B1); PG8_BAR; PG8_SCHED;
            PG8_LDA(At, 1, 1); PG8_STAGE(PG8_SB(1, 0), b3, voffB); PG8_STAGE(PG8_SB(1, 1), b3 + hstep, voffB); PG8_STAGE(PG8_SA(1, 0), a3, voffA);
            PG8_WAIT_V(8); PG8_WAIT_L(0); PG8_BAR; PG8_MMA(1, 0, At, B0); PG8_MMA(1, 1, At, B1); PG8_BAR; PG8_SCHED;
        }
        if (wr == 0) PG8_BAR;
        const bool keep = E(acc, cur, wr, wc, fr, fq, lds, tid);
        if (!has_next) break;
        if (!keep) {
#pragma unroll
            for (int a = 0; a < 2; ++a)
#pragma unroll
                for (int b = 0; b < 2; ++b)
#pragma unroll
                    for (int m = 0; m < 4; ++m)
#pragma unroll
                        for (int n = 0; n < 2; ++n) acc[a][b][m][n] = (f32x4){0.f, 0.f, 0.f, 0.f};
        }
        cur = nxt; cA = nA; cB = nB; ++ui;
        if (wr == 1) PG8_BAR;
    }
    PG8_WAIT_V(0);
    PG8_BAR;
#undef PG8_SA
#undef PG8_SB
#undef PG8_STAGE
#undef PG8_LDA
#undef PG8_LDB
#undef PG8_MMA
#undef PG8_WAIT_V
#undef PG8_WAIT_L
#undef PG8_SCHED
#undef PG8_UA
#undef PG8_UB
}
#define PG8_EPI_BARRIER() do { asm volatile("s_waitcnt lgkmcnt(0)" ::: "memory"); __builtin_amdgcn_s_barrier(); asm volatile("" ::: "memory"); } while (0)

template <int ACT> __device__ __forceinline__ u32x4 pack8(f32x4 v0, f32x4 v1, float sc) {
    float x[8] = {v0[0], v0[1], v0[2], v0[3], v1[0], v1[1], v1[2], v1[3]};
    u32x4 w;
    if (ACT == 2) {
        f16x8 h;
#pragma unroll
        for (int i = 0; i < 8; ++i) h[i] = (_Float16)sigmoidf_(x[i]);
        w = __builtin_bit_cast(u32x4, h);
    } else {
#pragma unroll
        for (int i = 0; i < 8; ++i) x[i] = (ACT == 1) ? x[i] * sigmoidf_(x[i]) : x[i] * sc;
        w.x = cvtpk(x[0], x[1]); w.y = cvtpk(x[2], x[3]); w.z = cvtpk(x[4], x[5]); w.w = cvtpk(x[6], x[7]);
    }
    return w;
}
template <int ACT> __device__ __forceinline__ void store_tile16(const Acc& acc, const Unit& u, int wr, int wc, int fr, int fq, bf16_t* base, int ld, int coff, float sc, const float* rstd) {
    const int row0 = u.pm * BM + wr * 64 + fr, col0 = coff + wc * 32 + 8 * fq;
#pragma unroll
    for (int ai = 0; ai < 2; ++ai)
#pragma unroll
        for (int m = 0; m < 4; ++m) { const int row = row0 + ai * HALF + m * 16; const float rs = rstd[row]; bf16_t* rowp = base + (size_t)row * ld + col0;
#pragma unroll
            for (int bj = 0; bj < 2; ++bj) *(u32x4*)(rowp + bj * HALF) = pack8<ACT>(acc[ai][bj][m][0] * rs, acc[ai][bj][m][1] * rs, sc); }
}
struct EpiIn {
    bf16_t *QA, *KA, *VA, *QB, *KB, *VB, *OG, *GA, *GB; float* GLOW; const float* rstd;
    __device__ __forceinline__ bool operator()(const Acc& acc, const Unit& u, int wr, int wc, int fr, int fq, LAS unsigned char*, int) const {
        const int pn = u.pn;
        if (pn < 4) store_tile16<0>(acc, u, wr, wc, fr, fq, QA, AQ, pn * 256, QA_SCALE, rstd);
        else if (pn == 4) store_tile16<0>(acc, u, wr, wc, fr, fq, KA, AKV, 0, 1.f, rstd);
        else if (pn == 5) store_tile16<0>(acc, u, wr, wc, fr, fq, VA, AKV, 0, 1.f, rstd);
        else if (pn < 8) store_tile16<0>(acc, u, wr, wc, fr, fq, QB, BQK, (pn - 6) * 256, 1.f, rstd);
        else if (pn < 10) store_tile16<0>(acc, u, wr, wc, fr, fq, KB, BQK, (pn - 8) * 256, 1.f, rstd);
        else if (pn < 14) store_tile16<0>(acc, u, wr, wc, fr, fq, VB, BV, (pn - 10) * 256, 1.f, rstd);
        else if (pn < 18) store_tile16<1>(acc, u, wr, wc, fr, fq, OG, BV, (pn - 14) * 256, 1.f, rstd);
        else if (pn < 26) store_tile16<2>(acc, u, wr, wc, fr, fq, GA, D, (pn - 18) * 256, 1.f, rstd);
        else if (pn < 34) store_tile16<2>(acc, u, wr, wc, fr, fq, GB, D, (pn - 26) * 256, 1.f, rstd);
        else if (wc == 0 && fq < 2) {
            const int row0 = u.pm * BM + wr * 64 + fr;
#pragma unroll
            for (int ai = 0; ai < 2; ++ai)
#pragma unroll
                for (int m = 0; m < 4; ++m) { const int row = row0 + ai * HALF + m * 16; const float rs = rstd[row]; float* p = GLOW + (size_t)row * RANK + 8 * fq;
                    *(f32x4*)p = acc[ai][0][m][0] * rs; *(f32x4*)(p + 4) = acc[ai][0][m][1] * rs; }
        }
        return false;
    }
};
struct EpiMerge {
    const _Float16 *GA, *GB; bf16_t* OUT;
    __device__ __forceinline__ bool operator()(Acc& acc, const Unit& u, int wr, int wc, int fr, int fq, LAS unsigned char*, int) const {
        const int row0 = u.pm * BM + wr * 64 + fr, col0 = u.pn * BM + wc * 32 + 8 * fq;
#pragma unroll
        for (int ai = 0; ai < 2; ++ai)
#pragma unroll
            for (int m = 0; m < 4; ++m) { const size_t off = (size_t)(row0 + ai * HALF + m * 16) * D + col0;
#pragma unroll
                for (int bj = 0; bj < 2; ++bj) {
                    const f16x8 gb = *(const f16x8*)(GB + off + bj * HALF);
                    if (u.seg == 0) {
                        const f16x8 ga = *(const f16x8*)(GA + off + bj * HALF);
#pragma unroll
                        for (int i = 0; i < 4; ++i) { acc[ai][bj][m][0][i] *= (float)ga[i] * __builtin_amdgcn_rcpf((float)gb[i]); acc[ai][bj][m][1][i] *= (float)ga[4 + i] * __builtin_amdgcn_rcpf((float)gb[4 + i]); }
                    } else {
                        f32x4 v0, v1;
#pragma unroll
                        for (int i = 0; i < 4; ++i) { v0[i] = acc[ai][bj][m][0][i] * (float)gb[i]; v1[i] = acc[ai][bj][m][1][i] * (float)gb[4 + i]; }
                        *(u32x4*)(OUT + off + bj * HALF) = pack8<0>(v0, v1, 1.f);
                    }
                } }
        return u.seg == 0;
    }
};
template <bool WITH_BF> struct EpiRes {
    const float* base; float* out; bf16_t* hb; float* stat;
    __device__ __forceinline__ bool operator()(const Acc& acc, const Unit& u, int wr, int wc, int fr, int fq, LAS unsigned char* lds, int tid) const {
        LAS float* XL = (LAS float*)(lds + XL_OFF);
        const int row0 = u.pm * BM + wr * 64 + fr, col0 = u.pn * BM + wc * 32 + 8 * fq;
#pragma unroll
        for (int ai = 0; ai < 2; ++ai)
#pragma unroll
            for (int m = 0; m < 4; ++m) { const int rl = ai * HALF + wr * 64 + m * 16 + fr; const size_t off = (size_t)(row0 + ai * HALF + m * 16) * D + col0; float ss = 0.f;
#pragma unroll
                for (int bj = 0; bj < 2; ++bj) {
                    const f32x4 b0 = *(const f32x4*)(base + off + bj * HALF), b1 = *(const f32x4*)(base + off + bj * HALF + 4);
                    const f32x4 h0 = b0 + acc[ai][bj][m][0], h1 = b1 + acc[ai][bj][m][1];
                    *(f32x4*)(out + off + bj * HALF) = h0; *(f32x4*)(out + off + bj * HALF + 4) = h1;
                    if (WITH_BF) *(u32x4*)(hb + off + bj * HALF) = pack8<0>(h0, h1, 1.f);
                    ss += (h0[0] * h0[0] + h0[1] * h0[1]) + (h0[2] * h0[2] + h0[3] * h0[3]) + (h1[0] * h1[0] + h1[1] * h1[1]) + (h1[2] * h1[2] + h1[3] * h1[3]);
                }
                ss += __shfl_xor(ss, 16); ss += __shfl_xor(ss, 32);
                if (fq == 0) XL[rl * 4 + wc] = ss; }
        PG8_EPI_BARRIER();
        if (tid < 256) { const f32x4 p = *(const LAS f32x4*)(XL + tid * 4); stat[(size_t)(u.pm * BM + tid) * 8 + u.pn] = (p[0] + p[1]) + (p[2] + p[3]); }
        PG8_EPI_BARRIER();
        return false;
    }
};
struct EpiGU {
    const float* stat; bf16_t* H;
    __device__ __forceinline__ bool operator()(const Acc& acc, const Unit& u, int wr, int wc, int fr, int fq, LAS unsigned char*, int) const {
        const int row0 = u.pm * BM + wr * 64 + fr, col0 = u.pn * HALF + wc * 32 + 8 * fq;
#pragma unroll
        for (int ai = 0; ai < 2; ++ai)
#pragma unroll
            for (int m = 0; m < 4; ++m) { const int row = row0 + ai * HALF + m * 16;
                const f32x4 s0 = *(const f32x4*)(stat + (size_t)row * 8), s1 = *(const f32x4*)(stat + (size_t)row * 8 + 4);
                const float rs = __builtin_amdgcn_rsqf(((s0[0] + s0[1]) + (s0[2] + s0[3]) + (s1[0] + s1[1]) + (s1[2] + s1[3])) * (1.f / D) + EPS);
                f32x4 v0, v1;
#pragma unroll
                for (int i = 0; i < 4; ++i) { const float g0 = acc[ai][0][m][0][i] * rs, g1 = acc[ai][0][m][1][i] * rs;
                    v0[i] = g0 * sigmoidf_(g0) * (acc[ai][1][m][0][i] * rs); v1[i] = g1 * sigmoidf_(g1) * (acc[ai][1][m][1][i] * rs); }
                *(u32x4*)(H + (size_t)row * FF + col0) = pack8<0>(v0, v1, 1.f); }
        return false;
    }
};
}

#define XB_TMO      128
#define XB_XCNT(j)  (256  + 64 * (j))
#define XB_XSUB(j)  (1280 + 64 * (j))
#define XB_XGEN(j)  (2304 + 64 * (j))
#define XB_TOP      3328
#define XB_TOPGEN   3392
#define XCD_BAR_WORDS 3456
#define XB_SPIN_CAP (1u << 18)
__device__ __forceinline__ unsigned xb_ld(unsigned* p)              { return __hip_atomic_load(p, __ATOMIC_RELAXED, __HIP_MEMORY_SCOPE_AGENT); }
__device__ __forceinline__ unsigned xb_add(unsigned* p, unsigned v) { return __hip_atomic_fetch_add(p, v, __ATOMIC_RELAXED, __HIP_MEMORY_SCOPE_AGENT); }
__device__ __forceinline__ unsigned xb_xcc_id() { return (unsigned)__builtin_amdgcn_s_getreg((3 << 11) | 20) & 0xFu; }
#define XB_SPIN(cond, bar) do { unsigned _sp = 0; while (cond) { __builtin_amdgcn_s_sleep(1); \
    if ((++_sp & 255u) == 0u) { if (xb_ld(&(bar)[XB_TMO])) break; if (_sp > XB_SPIN_CAP) { atomicAdd(&(bar)[XB_TMO], 1u); break; } } } } while (0)
struct XcdBarrier { unsigned* bar; unsigned x; volatile LAS unsigned* st; };
__device__ __forceinline__ XcdBarrier xcd_barrier_post(unsigned* bar, volatile LAS unsigned* st) {
    XcdBarrier b; b.bar = bar; b.x = xb_xcc_id(); b.st = st;
    if (threadIdx.x == 0) (void)xb_add(&bar[XB_XCNT(b.x)], 1u);
    return b;
}
__device__ __forceinline__ void xcd_barrier_complete(unsigned* bar, unsigned x, unsigned& nloc, unsigned& nx) {
    const unsigned G = gridDim.x * gridDim.y * gridDim.z;
    unsigned sum, cnt, mine, sp = 0u;
    for (;;) {
        sum = 0u; cnt = 0u; mine = 0u;
#pragma unroll
        for (unsigned j = 0; j < 16; ++j) { const unsigned c = xb_ld(&bar[XB_XCNT(j)]); sum += c; cnt += (c > 0u) ? 1u : 0u; mine = (j == x) ? c : mine; }
        if (sum == G) break;
        __builtin_amdgcn_s_sleep(1);
        if ((++sp & 255u) == 0u) { if (xb_ld(&bar[XB_TMO])) break; if (sp > XB_SPIN_CAP) { atomicAdd(&bar[XB_TMO], 1u); break; } }
    }
    nloc = mine > 0u ? mine : 1u; nx = cnt > 0u ? cnt : 1u;
}
__device__ __forceinline__ void xcd_barrier(const XcdBarrier& b) {
    asm volatile("s_waitcnt vmcnt(0)" ::: "memory");
    __syncthreads();
    if (threadIdx.x == 0) {
        unsigned* bar = b.bar;
        __builtin_amdgcn_s_waitcnt(0);
        unsigned nloc = b.st[0], nx = b.st[1];
        if (nloc == 0u) { xcd_barrier_complete(bar, b.x, nloc, nx); b.st[0] = nloc; b.st[1] = nx; }
        const unsigned old = xb_add(&bar[XB_XSUB(b.x)], 1u);
        const unsigned gen = old / nloc;
        if (old + 1u == (gen + 1u) * nloc) {
            __builtin_amdgcn_fence(__ATOMIC_RELEASE, "agent");
            asm volatile("s_waitcnt vmcnt(0)" ::: "memory");
            const unsigned og = xb_add(&bar[XB_TOP], 1u);
            const unsigned tg = og / nx;
            if (og + 1u == (tg + 1u) * nx) xb_add(&bar[XB_TOPGEN], 1u);
            else XB_SPIN(xb_ld(&bar[XB_TOPGEN]) == tg, bar);
            __builtin_amdgcn_fence(__ATOMIC_ACQUIRE, "agent");
            xb_add(&bar[XB_XGEN(b.x)], 1u);
            asm volatile("s_waitcnt vmcnt(0)" ::: "memory");
        } else {
            XB_SPIN(xb_ld(&bar[XB_XGEN(b.x)]) == gen, bar);
            __builtin_amdgcn_fence(__ATOMIC_ACQUIRE, "agent");
            asm volatile("s_waitcnt vmcnt(0)" ::: "memory");
        }
    }
    __syncthreads();
}

struct Args { const float* in[16]; float* out; unsigned char* ws; int ph_lo, ph_hi; };
struct Frame { LAS unsigned char* lds; int tid, lane, wave, G, bid; };

template <int MODE> __device__ __forceinline__ int dest_row(int n) {
    if (MODE == 1) return n < 3584 ? n : (n < 3600 ? 8704 + (n - 3584) : n - 16);
    if (MODE == 2) return 256 * (n >> 7) + (n & 127);
    if (MODE == 3) return 256 * (n >> 7) + 128 + (n & 127);
    return n;
}
template <int MODE> __device__ __forceinline__ void cvt_item64(const float* __restrict__ W, int K, int N, bf16_t* __restrict__ WT, const float* __restrict__ gk, LAS float* scr, int item, int lane) {
    const int nblk = (N + 63) >> 6, kb = item / nblk, nb = item - kb * nblk, k0 = 64 * kb, n0 = 64 * nb;
    const int nl4 = 4 * (lane & 15), kr = lane >> 4;
    const bool nok = (n0 + nl4) < N;
    f32x4 v[16];
#pragma unroll
    for (int j = 0; j < 16; ++j) v[j] = nok ? *(const f32x4*)(W + (size_t)(k0 + 4 * j + kr) * N + n0 + nl4) : (f32x4){0.f, 0.f, 0.f, 0.f};
    if (gk) {
#pragma unroll
        for (int j = 0; j < 16; ++j) v[j] = v[j] * gk[k0 + 4 * j + kr];
    }
#pragma unroll
    for (int j = 0; j < 16; ++j) { LAS float* d = scr + (4 * j + kr) * CV_S + nl4; d[0] = v[j][0]; d[1] = v[j][1]; d[2] = v[j][2]; d[3] = v[j][3]; }
    LDS_WAIT(); asm volatile("" ::: "memory");
    const int c = lane & 7;
#pragma unroll
    for (int jj = 0; jj < 8; ++jj) { const int n = (lane >> 3) + 8 * jj; const LAS float* sp = scr + (8 * c) * CV_S + n;
        u32x4 o; o.x = cvtpk(sp[0 * CV_S], sp[1 * CV_S]); o.y = cvtpk(sp[2 * CV_S], sp[3 * CV_S]); o.z = cvtpk(sp[4 * CV_S], sp[5 * CV_S]); o.w = cvtpk(sp[6 * CV_S], sp[7 * CV_S]);
        if (n0 + n < N) *(u32x4*)(WT + (size_t)dest_row<MODE>(n0 + n) * K + k0 + 8 * c) = o; }
    LDS_WAIT(); asm volatile("" ::: "memory");
}
__device__ __forceinline__ void p0_prologue(const Frame& F, const Args& a) {
    unsigned char* ws = a.ws;
    LAS float* scr = (LAS float*)(F.lds + F.wave * CV_BYTES);
    const int gw = F.bid * NWAVES + F.wave, NGW = F.G * NWAVES;
    constexpr int I_IN = (D / 64) * ((IN_W + 63) / 64);
    for (int it = gw; it < I_IN; it += NGW) cvt_item64<1>(a.in[2], D, IN_W, (bf16_t*)(ws + WS_WIN), a.in[1], scr, it, F.lane);
    { u32x4* z = (u32x4*)(ws + WS_WIN + (size_t)IN_W * D * 2); const int nz = (NIN - IN_W) * D * 2 / 16;
      for (int i = F.bid * 512 + F.tid; i < nz; i += F.G * 512) z[i] = (u32x4){0u, 0u, 0u, 0u}; }
    const float* x = a.in[0]; bf16_t* XB = (bf16_t*)(ws + WS_XB); float* RS = (float*)(ws + WS_RSTD1);
    for (int m = 2 * gw; m < M; m += 2 * NGW) {
        const f32x4* xr = (const f32x4*)(x + (size_t)m * D) + F.lane; f32x4 v[2][8]; float s0 = 0.f, s1 = 0.f;
#pragma unroll
        for (int j = 0; j < 8; ++j) { v[0][j] = xr[64 * j]; v[1][j] = xr[512 + 64 * j]; }
#pragma unroll
        for (int j = 0; j < 8; ++j) { s0 += (v[0][j][0] * v[0][j][0] + v[0][j][1] * v[0][j][1]) + (v[0][j][2] * v[0][j][2] + v[0][j][3] * v[0][j][3]);
                                      s1 += (v[1][j][0] * v[1][j][0] + v[1][j][1] * v[1][j][1]) + (v[1][j][2] * v[1][j][2] + v[1][j][3] * v[1][j][3]); }
        u32x2* o = (u32x2*)(XB + (size_t)m * D) + F.lane;
#pragma unroll
        for (int j = 0; j < 8; ++j) { o[64 * j] = (u32x2){cvtpk(v[0][j][0], v[0][j][1]), cvtpk(v[0][j][2], v[0][j][3])}; o[512 + 64 * j] = (u32x2){cvtpk(v[1][j][0], v[1][j][1]), cvtpk(v[1][j][2], v[1][j][3])}; }
        s0 = wave_sum(s0); s1 = wave_sum(s1);
        if (F.lane == 0) { RS[m] = __builtin_amdgcn_rsqf(s0 * (1.f / D) + EPS); RS[m + 1] = __builtin_amdgcn_rsqf(s1 * (1.f / D) + EPS); }
    }
}
__device__ __forceinline__ void cvt_tail_a(const Frame& F, const Args& a, int ti, int nt) {
    unsigned char* ws = a.ws;
    LAS float* scr = (LAS float*)(F.lds + F.wave * CV_BYTES);
    const int gw = ti * NWAVES + F.wave, NGW = nt * NWAVES;
    constexpr int I_PA = (AQ / 64) * (D / 64), I_PB = (BV / 64) * (D / 64), I_WO = (D / 64) * (D / 64), I_G = (D / 64) * (FF / 64);
    constexpr int NITEMS = I_PA + I_PB + I_WO + 2 * I_G;
    for (int it = gw; it < NITEMS; it += NGW) {
        int r = it;
        if (r < I_PA) { cvt_item64<0>(a.in[8], AQ, D, (bf16_t*)(ws + WS_PA), nullptr, scr, r, F.lane); continue; } r -= I_PA;
        if (r < I_PB) { cvt_item64<0>(a.in[9], BV, D, (bf16_t*)(ws + WS_PB), nullptr, scr, r, F.lane); continue; } r -= I_PB;
        if (r < I_WO) { cvt_item64<0>(a.in[10], D, D, (bf16_t*)(ws + WS_WOUT), nullptr, scr, r, F.lane); continue; } r -= I_WO;
        if (r < I_G) { cvt_item64<2>(a.in[12], D, FF, (bf16_t*)(ws + WS_WGU), a.in[11], scr, r, F.lane); continue; } r -= I_G;
        cvt_item64<3>(a.in[13], D, FF, (bf16_t*)(ws + WS_WGU), a.in[11], scr, r, F.lane);
    }
}
__device__ __forceinline__ void cvt_tail_b(const Frame& F, const Args& a, int ti, int nt) {
    LAS float* scr = (LAS float*)(F.lds + F.wave * CV_BYTES);
    const int gw = ti * NWAVES + F.wave, NGW = nt * NWAVES;
    constexpr int I_D = (FF / 64) * (D / 64);
    for (int it = gw; it < I_D; it += NGW) cvt_item64<0>(a.in[14], FF, D, (bf16_t*)(a.ws + WS_WD), nullptr, scr, it, F.lane);
}

__device__ __forceinline__ unsigned short elem16(const u32x4& v, int e) { const unsigned w = v[e >> 1]; return (unsigned short)((e & 1) ? (w >> 16) : (w & 0xffffu)); }
constexpr int SW_KS = 72, SW_VS = 264;
__device__ __forceinline__ void swa_unit(const Frame& F, const Args& a, int u) {
    const int b = u >> 7, blk = (u >> 2) & 31, kvh = u & 3;
    const int tid = F.tid, lane = F.lane, w = F.wave, l31 = lane & 31, hi = lane >> 5;
    unsigned char* ws = a.ws;
    bf16_t* QA = (bf16_t*)(ws + WS_QA); const bf16_t* KA = (const bf16_t*)(ws + WS_KA); const bf16_t* VA = (const bf16_t*)(ws + WS_VA);
    LAS bf16_t* Ks = (LAS bf16_t*)(F.lds);
    LAS bf16_t* VT = (LAS bf16_t*)(F.lds + 256 * SW_KS * 2);
    LAS float* BT = (LAS float*)(F.lds + 256 * SW_KS * 2 + 64 * SW_VS * 2);
    const long r0 = (long)b * SEQ + blk * 128;
#pragma unroll
    for (int i = 0; i < 4; ++i) { const int p = tid + 512 * i, row = p >> 3, ch = p & 7; const long grow = r0 - 128 + row;
        u32x4 kv = (u32x4){0u, 0u, 0u, 0u}, vv = (u32x4){0u, 0u, 0u, 0u};
        if (blk > 0 || row >= 128) { kv = *(const u32x4*)(KA + grow * AKV + kvh * 64 + ch * 8); vv = *(const u32x4*)(VA + grow * AKV + kvh * 64 + ch * 8); }
        *(LAS u32x4*)(Ks + row * SW_KS + ch * 8) = kv;
#pragma unroll
        for (int e = 0; e < 8; ++e) VT[(ch * 8 + e) * SW_VS + row] = elem16(vv, e); }
    { const int hq = tid >> 7, dist = tid & 127;
      int bucket = dist;
      if (dist >= 16) { bucket = 16 + (int)(__logf((float)dist * (1.f / 16.f)) * (16.f / 2.0794415416798357f)); bucket = bucket > 31 ? 31 : bucket; }
      BT[tid] = a.in[4][bucket * 16 + kvh * 4 + hq] * LOG2E; }
    __syncthreads();
    const int hq = w >> 1, head = kvh * 4 + hq;
    const float sinkv = a.in[3][head] * LOG2E;
#pragma unroll 1
    for (int qt = 0; qt < 2; ++qt) {
        const int i0 = 64 * (w & 1) + 32 * qt;
        bf16x8 qf[4];
#pragma unroll
        for (int ds = 0; ds < 4; ++ds) qf[ds] = *(const bf16x8*)(QA + (r0 + i0 + l31) * AQ + head * 64 + 16 * ds + 8 * hi);
        f32x16 p[5];
#pragma unroll
        for (int kt = 0; kt < 5; ++kt) { p[kt] = (f32x16){};
#pragma unroll
            for (int ds = 0; ds < 4; ++ds) { const bf16x8 kf = *(const LAS bf16x8*)(Ks + (i0 + 32 * kt + l31) * SW_KS + 16 * ds + 8 * hi);
                p[kt] = __builtin_amdgcn_mfma_f32_32x32x16_bf16(kf, qf[ds], p[kt], 0, 0, 0); } }
        const int q = i0 + l31; float mx = sinkv;
#pragma unroll
        for (int kt = 0; kt < 5; ++kt)
#pragma unroll
            for (int r = 0; r < 16; ++r) { const int j = i0 + 32 * kt + crow(r, hi), dist = q + 128 - j;
                const bool valid = dist >= 0 && dist < 128 && (blk > 0 || j >= 128);
                const float s = valid ? p[kt][r] + BT[hq * 128 + (dist & 127)] : -1e30f;
                p[kt][r] = s; mx = fmaxf(mx, s); }
        mx = fmaxf(mx, __shfl_xor(mx, 32));
        float sum = 0.f;
#pragma unroll
        for (int kt = 0; kt < 5; ++kt)
#pragma unroll
            for (int r = 0; r < 16; ++r) { const float e = __builtin_amdgcn_exp2f(p[kt][r] - mx); p[kt][r] = e; sum += e; }
        sum += __shfl_xor(sum, 32);
        sum += __builtin_amdgcn_exp2f(sinkv - mx);
        const float inv = 1.f / sum;
        f32x16 o[2]; o[0] = (f32x16){}; o[1] = (f32x16){};
#pragma unroll
        for (int kt = 0; kt < 5; ++kt)
#pragma unroll
            for (int s2 = 0; s2 < 2; ++s2) {
                u32x4 pw;
#pragma unroll
                for (int i = 0; i < 4; ++i) pw[i] = cvtpk(p[kt][8 * s2 + 2 * i] * inv, p[kt][8 * s2 + 2 * i + 1] * inv);
                const bf16x8 pa = __builtin_bit_cast(bf16x8, pw);
#pragma unroll
                for (int dh = 0; dh < 2; ++dh) { const LAS bf16_t* vp = VT + (32 * dh + l31) * SW_VS + i0 + 32 * kt + 16 * s2 + 4 * hi;
                    const s16x4 lo = *(const LAS s16x4*)vp, hi4 = *(const LAS s16x4*)(vp + 8);
                    const bf16x8 vb = (bf16x8){lo[0], lo[1], lo[2], lo[3], hi4[0], hi4[1], hi4[2], hi4[3]};
                    o[dh] = __builtin_amdgcn_mfma_f32_32x32x16_bf16(pa, vb, o[dh], 0, 0, 0); } }
#pragma unroll
        for (int dh = 0; dh < 2; ++dh)
#pragma unroll
            for (int r = 0; r < 16; ++r) QA[(r0 + i0 + crow(r, hi)) * AQ + head * 64 + 32 * dh + l31] = f2bf(o[dh][r]);
    }
    __syncthreads();
}

constexpr int GL_S = 72;
__device__ __forceinline__ void gla_stage_vt(const Frame& F, const bf16_t* VB, long t0, int h, LAS bf16_t* VT) {
#pragma unroll
    for (int i = 0; i < 4; ++i) { const int p = F.tid + 512 * i, s = p >> 5, ch = p & 31;
        const u32x4 vv = *(const u32x4*)(VB + (t0 + s) * BV + h * 256 + ch * 8);
#pragma unroll
        for (int e = 0; e < 8; ++e) VT[(ch * 8 + e) * GL_S + s] = elem16(vv, e); }
}
__device__ __forceinline__ void gla_a_unit(const Frame& F, const Args& a, int u) {
    const int b = u >> 8, h = (u >> 6) & 3, c = u & 63;
    const int tid = F.tid, lane = F.lane, w = F.wave, l31 = lane & 31, hi = lane >> 5;
    unsigned char* ws = a.ws;
    bf16_t* QB = (bf16_t*)(ws + WS_QB); bf16_t* KB = (bf16_t*)(ws + WS_KB); const bf16_t* VB = (const bf16_t*)(ws + WS_VB);
    const float* GLOW = (const float*)(ws + WS_GLOW); float* DEC = (float*)(ws + WS_DEC); bf16_t* ST = (bf16_t*)(ws + WS_STATE) + (size_t)u * 32768;
    LAS float* GL = (LAS float*)F.lds;
    LAS float* TOT = (LAS float*)(F.lds + 4096);
    LAS bf16_t* KsT = (LAS bf16_t*)(F.lds + 8192);
    LAS bf16_t* VT = (LAS bf16_t*)(F.lds + 8192 + 128 * GL_S * 2);
    const long t0 = (long)b * SEQ + 64 * c;
    if (tid < 256) *(LAS f32x4*)(GL + tid * 4) = *(const f32x4*)(GLOW + (size_t)t0 * RANK + tid * 4);
    gla_stage_vt(F, VB, t0, h, VT);
    const int d = tid & 127, sg = tid >> 7;
    float wg[16];
#pragma unroll
    for (int r = 0; r < 16; ++r) wg[r] = a.in[5][r * BQK + h * 128 + d];
    const float bg = a.in[6][h * 128 + d];
    __syncthreads();
    float bl[16]; float run = 0.f;
#pragma unroll
    for (int i = 0; i < 16; ++i) { const int s = sg * 16 + i; float G = bg;
#pragma unroll
        for (int r4 = 0; r4 < 4; ++r4) { const f32x4 gv = *(const LAS f32x4*)(GL + s * 16 + r4 * 4); G += gv[0] * wg[4 * r4] + gv[1] * wg[4 * r4 + 1] + gv[2] * wg[4 * r4 + 2] + gv[3] * wg[4 * r4 + 3]; }
        const float ls = fminf(G, 0.f) - __logf(1.f + __expf(-fabsf(G)));
        run += ls * (1.f / 16.f); bl[i] = run; }
    TOT[sg * 128 + d] = run;
    __syncthreads();
    float off = 0.f, tot = 0.f;
#pragma unroll
    for (int g = 0; g < 4; ++g) { const float t = TOT[g * 128 + d]; if (g < sg) off += t; tot += t; }
#pragma unroll
    for (int i = 0; i < 16; ++i) { const int s = sg * 16 + i; const float bb = off + bl[i]; const size_t gi = (size_t)(t0 + s) * BQK + h * 128 + d;
        const float qv = bf2f(QB[gi]), kv = bf2f(KB[gi]);
        QB[gi] = f2bf(qv * __expf(bb) * QB_SCALE); KB[gi] = f2bf(kv * __expf(-bb)); KsT[d * GL_S + s] = f2bf(kv * __expf(tot - bb)); }
    if (sg == 0) DEC[u * 128 + d] = __expf(tot);
    __syncthreads();
    bf16x8 af[4];
#pragma unroll
    for (int st = 0; st < 4; ++st) af[st] = *(const LAS bf16x8*)(VT + (32 * w + l31) * GL_S + 16 * st + 8 * hi);
#pragma unroll
    for (int dt = 0; dt < 4; ++dt) { f32x16 acc = (f32x16){};
#pragma unroll
        for (int st = 0; st < 4; ++st) { const bf16x8 bfr = *(const LAS bf16x8*)(KsT + (32 * dt + l31) * GL_S + 16 * st + 8 * hi); acc = __builtin_amdgcn_mfma_f32_32x32x16_bf16(af[st], bfr, acc, 0, 0, 0); }
#pragma unroll
        for (int r = 0; r < 16; ++r) ST[(32 * w + crow(r, hi)) * 128 + 32 * dt + l31] = f2bf(acc[r]); }
    __syncthreads();
}

__device__ __forceinline__ void gla_scan(const Frame& F, const Args& a) {
    unsigned char* ws = a.ws; unsigned* ST = (unsigned*)(ws + WS_STATE); const float* DEC = (const float*)(ws + WS_DEC);
    for (int idx = F.bid * 512 + F.tid; idx < 8 * 16384; idx += F.G * 512) {
        const int bh = idx >> 14, e2 = idx & 16383, d0 = (e2 * 2) & 127;
        unsigned* p = ST + (size_t)bh * 64 * 16384 + e2; const float* dp = DEC + (size_t)bh * 64 * 128 + d0;
        float s0 = 0.f, s1 = 0.f;
#pragma unroll 8
        for (int c = 0; c < 64; ++c) { const unsigned x = p[(size_t)c * 16384]; const f32x2 dc = *(const f32x2*)(dp + c * 128);
            p[(size_t)c * 16384] = cvtpk(s0, s1); s0 = dc[0] * s0 + bflo(x); s1 = dc[1] * s1 + bfhi(x); }
    }
}

constexpr int OS_S = 260;
__device__ __forceinline__ void gla_c_unit(const Frame& F, const Args& a, int u) {
    const int b = u >> 8, h = (u >> 6) & 3, c = u & 63;
    const int lane = F.lane, w = F.wave, l31 = lane & 31, hi = lane >> 5;
    unsigned char* ws = a.ws;
    const bf16_t* QB = (const bf16_t*)(ws + WS_QB); const bf16_t* KB = (const bf16_t*)(ws + WS_KB); bf16_t* VB = (bf16_t*)(ws + WS_VB);
    const bf16_t* OG = (const bf16_t*)(ws + WS_OG); const bf16_t* ST = (const bf16_t*)(ws + WS_STATE) + (size_t)u * 32768;
    LAS bf16_t* VT = (LAS bf16_t*)F.lds;
    LAS float* OS = (LAS float*)(F.lds + 256 * GL_S * 2);
    const long t0 = (long)b * SEQ + 64 * c;
    gla_stage_vt(F, VB, t0, h, VT);
    const int ct = w & 1, vt0 = (w >> 1) * 2;
    bf16x8 qf[8];
#pragma unroll
    for (int st = 0; st < 8; ++st) qf[st] = *(const bf16x8*)(QB + (t0 + 32 * ct + l31) * BQK + h * 128 + 16 * st + 8 * hi);
    f32x16 aT[2];
#pragma unroll
    for (int sti = 0; sti < 2; ++sti) { aT[sti] = (f32x16){};
        if (sti <= ct) {
#pragma unroll
            for (int st = 0; st < 8; ++st) { const bf16x8 kf = *(const bf16x8*)(KB + (t0 + 32 * sti + l31) * BQK + h * 128 + 16 * st + 8 * hi);
                aT[sti] = __builtin_amdgcn_mfma_f32_32x32x16_bf16(kf, qf[st], aT[sti], 0, 0, 0); }
#pragma unroll
            for (int r = 0; r < 16; ++r) if (32 * sti + crow(r, hi) > 32 * ct + l31) aT[sti][r] = 0.f;
        } }
    __syncthreads();
    f32x16 o[2];
#pragma unroll
    for (int j = 0; j < 2; ++j) { o[j] = (f32x16){};
        const int vrow = 32 * (vt0 + j) + l31;
#pragma unroll
        for (int st = 0; st < 8; ++st) { const bf16x8 sf = *(const bf16x8*)(ST + vrow * 128 + 16 * st + 8 * hi); o[j] = __builtin_amdgcn_mfma_f32_32x32x16_bf16(qf[st], sf, o[j], 0, 0, 0); }
#pragma unroll
        for (int sti = 0; sti < 2; ++sti) if (sti <= ct) {
#pragma unroll
            for (int s2 = 0; s2 < 2; ++s2) { u32x4 pw;
#pragma unroll
                for (int i = 0; i < 4; ++i) pw[i] = cvtpk(aT[sti][8 * s2 + 2 * i], aT[sti][8 * s2 + 2 * i + 1]);
                const LAS bf16_t* vp = VT + vrow * GL_S + 32 * sti + 16 * s2 + 4 * hi;
                const s16x4 lo = *(const LAS s16x4*)vp, hi4 = *(const LAS s16x4*)(vp + 8);
                const bf16x8 vb = (bf16x8){lo[0], lo[1], lo[2], lo[3], hi4[0], hi4[1], hi4[2], hi4[3]};
                o[j] = __builtin_amdgcn_mfma_f32_32x32x16_bf16(__builtin_bit_cast(bf16x8, pw), vb, o[j], 0, 0, 0); } }
#pragma unroll
        for (int r = 0; r < 16; ++r) OS[(32 * ct + crow(r, hi)) * OS_S + 32 * (vt0 + j) + l31] = o[j][r]; }
    __syncthreads();
    const f32x4 gn = *(const f32x4*)(a.in[7] + 4 * lane);
#pragma unroll
    for (int i = 0; i < 8; ++i) { const int row = 8 * w + i; const f32x4 v = *(const LAS f32x4*)(OS + row * OS_S + 4 * lane);
        const float ss = wave_sum((v[0] * v[0] + v[1] * v[1]) + (v[2] * v[2] + v[3] * v[3]));
        const float rs = __builtin_amdgcn_rsqf(ss * (1.f / 256.f) + EPS);
        const size_t gi = (size_t)(t0 + row) * BV + h * 256 + 4 * lane; const u32x2 og = *(const u32x2*)(OG + gi);
        *(u32x2*)(VB + gi) = (u32x2){cvtpk(v[0] * rs * gn[0] * bflo(og[0]), v[1] * rs * gn[1] * bfhi(og[0])), cvtpk(v[2] * rs * gn[2] * bflo(og[1]), v[3] * rs * gn[3] * bfhi(og[1]))}; }
    __syncthreads();
}

__device__ __forceinline__ void final_norm(const Frame& F, const Args& a) {
    const float* stat = (const float*)(a.ws + WS_STAT3); const float* gf = a.in[15];
    const int gw = F.bid * NWAVES + F.wave, NGW = F.G * NWAVES;
    for (int m = gw; m < M; m += NGW) {
        const f32x4 s0 = *(const f32x4*)(stat + (size_t)m * 8), s1 = *(const f32x4*)(stat + (size_t)m * 8 + 4);
        const float rs = __builtin_amdgcn_rsqf(((s0[0] + s0[1]) + (s0[2] + s0[3]) + (s1[0] + s1[1]) + (s1[2] + s1[3])) * (1.f / D) + EPS);
        f32x4* xr = (f32x4*)(a.out + (size_t)m * D) + F.lane; const f32x4* gr = (const f32x4*)gf + F.lane;
        f32x4 v[8];
#pragma unroll
        for (int j = 0; j < 8; ++j) v[j] = xr[64 * j];
#pragma unroll
        for (int j = 0; j < 8; ++j) xr[64 * j] = v[j] * rs * gr[64 * j];
    }
}

#ifndef MK_PROBE
#define MK_PROBE 0
#endif
#if MK_PROBE == 1
#define MK_PROG 0, 0, 1, 2, 3, 4, 5, 6, 7, 8, 9
#elif MK_PROBE == 2
#define MK_PROG 0, 1, 1, 2, 3, 4, 5, 6, 7, 8, 9
#elif MK_PROBE == 3
#define MK_PROG 0, 1, 2, 3, 4, 0, 1, 2, 3, 4, 5, 6, 7, 8, 9
#elif MK_PROBE == 4
#define MK_PROG 0, 1, 2, 3, 4, 5, 6, 7, 6, 7, 8, 9
#elif MK_PROBE == 5
#define MK_PROG 0, 1, 2, 3, 4, 5, 5, 6, 7, 8, 9
#elif MK_PROBE == 6
#define MK_PROG 0, 1, 2, 3, 4, 5, 6, 7, 8, 6, 7, 8, 9
#else
#define MK_PROG 0, 1, 2, 3, 4, 5, 6, 7, 8, 9
#endif
template <int PH> __device__ __forceinline__ void run_phase(const Frame& F, const Args& args) {
    unsigned char* ws = args.ws;
    if constexpr (PH == 0) { p0_prologue(F, args); }
    else if constexpr (PH == 1) {
        pg8::Gemm g{(const bf16_t*)(ws + WS_XB), nullptr, (const bf16_t*)(ws + WS_WIN), nullptr, D};
        pg8::StaticOrder S; S.init(M, NIN, F.G, F.bid, 0);
        pg8::EpiIn E{(bf16_t*)(ws + WS_QA), (bf16_t*)(ws + WS_KA), (bf16_t*)(ws + WS_VA), (bf16_t*)(ws + WS_QB), (bf16_t*)(ws + WS_KB), (bf16_t*)(ws + WS_VB), (bf16_t*)(ws + WS_OG),
                     (bf16_t*)(ws + WS_GA), (bf16_t*)(ws + WS_GB), (float*)(ws + WS_GLOW), (const float*)(ws + WS_RSTD1)};
        pg8::gemm_phase(F.lds, g, S, E);
        { const int rem = S.nwg % F.G; if (rem == 0) cvt_tail_a(F, args, F.bid, F.G); else if (F.bid >= rem) cvt_tail_a(F, args, F.bid - rem, F.G - rem); }
    } else if constexpr (PH == 2) {
        for (int u = F.bid; u < 256; u += F.G) swa_unit(F, args, u);
        for (int u = F.bid; u < 512; u += F.G) gla_a_unit(F, args, u);
    } else if constexpr (PH == 3) { gla_scan(F, args); }
    else if constexpr (PH == 4) { for (int u = F.bid; u < 512; u += F.G) gla_c_unit(F, args, u); }
    else if constexpr (PH == 5) {
        pg8::Gemm g{(const bf16_t*)(ws + WS_QA), (const bf16_t*)(ws + WS_VB), (const bf16_t*)(ws + WS_PA), (const bf16_t*)(ws + WS_PB), AQ};
        pg8::StaticOrder S; S.init(M, D, F.G, F.bid, 1);
        pg8::EpiMerge E{(const _Float16*)(ws + WS_GA), (const _Float16*)(ws + WS_GB), (bf16_t*)(ws + WS_MERGED)};
        pg8::gemm_phase(F.lds, g, S, E);
    } else if constexpr (PH == 6) {
        pg8::Gemm g{(const bf16_t*)(ws + WS_MERGED), nullptr, (const bf16_t*)(ws + WS_WOUT), nullptr, D};
        pg8::StaticOrder S; S.init(M, D, F.G, F.bid, 0);
        pg8::EpiRes<true> E{args.in[0], args.out, (bf16_t*)(ws + WS_HB), (float*)(ws + WS_STAT2)};
        pg8::gemm_phase(F.lds, g, S, E);
    } else if constexpr (PH == 7) {
        pg8::Gemm g{(const bf16_t*)(ws + WS_HB), nullptr, (const bf16_t*)(ws + WS_WGU), nullptr, D};
        pg8::StaticOrder S; S.init(M, 2 * FF, F.G, F.bid, 0);
        pg8::EpiGU E{(const float*)(ws + WS_STAT2), (bf16_t*)(ws + WS_H)};
        pg8::gemm_phase(F.lds, g, S, E);
        { const int rem = S.nwg % F.G; if (rem == 0) cvt_tail_b(F, args, F.bid, F.G); else if (F.bid >= rem) cvt_tail_b(F, args, F.bid - rem, F.G - rem); }
    } else if constexpr (PH == 8) {
        pg8::Gemm g{(const bf16_t*)(ws + WS_H), nullptr, (const bf16_t*)(ws + WS_WD), nullptr, FF};
        pg8::StaticOrder S; S.init(M, D, F.G, F.bid, 0);
        pg8::EpiRes<false> E{args.out, args.out, nullptr, (float*)(ws + WS_STAT3)};
        pg8::gemm_phase(F.lds, g, S, E);
    } else { final_norm(F, args); }
}
template <int I, int PH> __device__ __forceinline__ void run_step(const Frame& F, const Args& args, const XcdBarrier& bar) {
    if (args.ph_lo <= I && I < args.ph_hi) { if (I > args.ph_lo) xcd_barrier(bar); run_phase<PH>(F, args); }
}
template <int... PH, int... I> __device__ __forceinline__ void run_prog(std::integer_sequence<int, PH...>, std::integer_sequence<int, I...>, const Frame& F, const Args& args, const XcdBarrier& bar) {
    (run_step<I, PH>(F, args, bar), ...);
}
typedef std::integer_sequence<int, MK_PROG> ProgSeq;
constexpr int N_PROG = (int)ProgSeq::size();
__global__ void __launch_bounds__(NWAVES * 64, 2) fwd_kernel(Args args) {
    extern __shared__ __attribute__((aligned(16))) unsigned char lds_raw[];
    Frame F;
    F.lds = (LAS unsigned char*)lds_raw;
    F.tid = threadIdx.x; F.lane = F.tid & 63; F.wave = __builtin_amdgcn_readfirstlane(F.tid >> 6);
    F.G = gridDim.x; F.bid = blockIdx.x;
    volatile LAS unsigned* MISC = (volatile LAS unsigned*)(F.lds + CTL_OFF);
    if (F.tid < 16) MISC[F.tid] = 0u;
    __syncthreads();
    const XcdBarrier bar = xcd_barrier_post((unsigned*)(args.ws + WS_BAR), MISC + 8);
    run_prog(ProgSeq{}, std::make_integer_sequence<int, N_PROG>{}, F, args, bar);
}

extern "C" void kernel_launch(void* const* d_in, const int* in_sizes, int n_in, void* d_out, int out_size, void* d_ws, size_t ws_size, hipStream_t stream) {
    static int grid = 0;
    if (grid == 0) {
        if (n_in != 16 || in_sizes[0] != M * D || out_size != M * D || ws_size < WS_END) { fprintf(stderr, "kernel_launch: unexpected shapes (n_in %d, in0 %d, out %d, ws %zu); nothing launched\n", n_in, n_in > 0 ? in_sizes[0] : -1, out_size, ws_size); grid = -1; return; }
        int dev = 0, cus = 0, per_cu = 0;
        if (hipGetDevice(&dev) != hipSuccess || hipDeviceGetAttribute(&cus, hipDeviceAttributeMultiprocessorCount, dev) != hipSuccess) { grid = -1; return; }
        if (hipFuncSetAttribute((const void*)fwd_kernel, hipFuncAttributeMaxDynamicSharedMemorySize, LDS_BYTES) != hipSuccess) { fprintf(stderr, "kernel_launch: hipFuncSetAttribute failed\n"); grid = -1; return; }
        if (hipOccupancyMaxActiveBlocksPerMultiprocessor(&per_cu, (const void*)fwd_kernel, NWAVES * 64, LDS_BYTES) != hipSuccess || per_cu < 1) { fprintf(stderr, "kernel_launch: occupancy query failed (%d)\n", per_cu); (void)hipGetLastError(); per_cu = 1; }
        if (per_cu > 1) per_cu = 1;
        grid = cus * per_cu;
    }
    if (grid < 0) return;
    if (hipMemsetAsync((char*)d_ws + WS_BAR, 0, 16384, stream) != hipSuccess) { fprintf(stderr, "kernel_launch: memset failed\n"); return; }
    Args a{};
    for (int i = 0; i < 16; ++i) a.in[i] = (const float*)d_in[i];
    a.out = (float*)d_out; a.ws = (unsigned char*)d_ws;
#if MK_N_LAUNCHES == 1
    a.ph_lo = 0; a.ph_hi = N_PROG;
    void* kargs[] = {&a};
    hipError_t e = hipLaunchCooperativeKernel((const void*)fwd_kernel, dim3(grid), dim3(NWAVES * 64), kargs, LDS_BYTES, stream);
    if (e != hipSuccess) fprintf(stderr, "kernel_launch: cooperative launch failed: %s (grid %d)\n", hipGetErrorString(e), grid);
#else
    for (int ph = 0; ph < N_PROG; ++ph) { a.ph_lo = ph; a.ph_hi = ph + 1; hipLaunchKernelGGL(fwd_kernel, dim3(grid), dim3(NWAVES * 64), LDS_BYTES, stream, a); }
#endif
}
```
